# Optimizing an MI355X kernel written in HIP

```python
import math
import jax, jax.numpy as jnp
from jax import lax
import numpy as np

D_MODEL = 2048
BATCH = 2
SEQ = 4096
DEPTH = 2
DEC_BATCH = 1
DEC_SEQ = 8192
PAST_LEN = 128

GRID_W = 64
Q_BLOCK = 128
EPS = 1e-6
ROPE_THETA = 10000.0
NUM_BUCKETS = 32
MAX_DISTANCE = 128
A_HEADS = 8
A_QK_DIM = 64
A_V_DIM = 128
A_OUT = A_HEADS * A_V_DIM
B_Q_HEADS = 8
B_KV_HEADS = 2
B_GROUP = B_Q_HEADS // B_KV_HEADS
B_DIM = 128
B_OUT = B_Q_HEADS * B_DIM
C_HEADS = 8
C_Q_RANK = 512
C_KV_RANK = 256
C_NOPE = 128
C_ROPE = 64
C_V = 128
C_OUT = C_HEADS * C_V
N_BRANCH = 3
X_HEADS = 4
X_DIM = 128
MEM_TOKENS = 256
D_FF = -(-8 * D_MODEL // (3 * 256)) * 256
IN_SIZES = (A_HEADS * 2 * A_QK_DIM, A_HEADS * 2 * A_QK_DIM, A_OUT,
            B_Q_HEADS * B_DIM, B_KV_HEADS * B_DIM, B_KV_HEADS * B_DIM,
            C_Q_RANK, C_KV_RANK, C_ROPE, N_BRANCH * D_MODEL)
IN_COLS = sum(IN_SIZES)

kernel_name = "hybrid_bidir_encoder_gated_parallel"

F32 = jnp.float32


def rms_norm(x, g):
    xf = x.astype(F32)
    y = xf * lax.rsqrt(jnp.mean(xf * xf, axis=-1, keepdims=True) + EPS)
    return (y * g.astype(F32)).astype(x.dtype)


def rope(x, pos):
    d = x.shape[-1]
    inv = ROPE_THETA ** (-jnp.arange(0, d, 2, dtype=F32) / d)
    ang = pos.astype(F32)[:, None] * inv[None, :]
    cos, sin = jnp.cos(ang).astype(x.dtype), jnp.sin(ang).astype(x.dtype)
    x1, x2 = jnp.split(x, 2, axis=-1)
    return jnp.concatenate([x1 * cos - x2 * sin, x1 * sin + x2 * cos], axis=-1)


def axial_rope(x, row_pos, col_pos):
    half = x.shape[-1] // 2
    return jnp.concatenate([rope(x[..., :half], row_pos), rope(x[..., half:], col_pos)], axis=-1)


def t5_bucket(rel):
    nb = NUM_BUCKETS // 2
    max_exact = nb // 2
    ret = (rel > 0).astype(jnp.int32) * nb
    n = jnp.abs(rel)
    nf = jnp.maximum(n, 1).astype(F32)
    large = max_exact + (jnp.log(nf / max_exact) / math.log(MAX_DISTANCE / max_exact)
                         * (nb - max_exact)).astype(jnp.int32)
    large = jnp.minimum(large, nb - 1)
    return ret + jnp.where(n < max_exact, n, large)


def sweep_blocks(block_fn, seq_len):
    out = lax.map(block_fn, jnp.arange(seq_len // Q_BLOCK))
    nblk, b, h, qb, dv = out.shape
    return out.transpose(1, 0, 3, 2, 4).reshape(b, nblk * qb, h, dv)


def diff_attention(q1, q2, k1, k2, v, rel_bias, lam):
    S = q1.shape[2]
    scale = A_QK_DIM ** -0.5
    kpos = jnp.arange(S)
    table = rel_bias.T.astype(F32)

    def block(i):
        s0 = i * Q_BLOCK
        qa = lax.dynamic_slice_in_dim(q1, s0, Q_BLOCK, axis=2)
        qb = lax.dynamic_slice_in_dim(q2, s0, Q_BLOCK, axis=2)
        qpos = s0 + jnp.arange(Q_BLOCK)
        bias = table[:, t5_bucket(kpos[None, :] - qpos[:, None])]
        p1 = jax.nn.softmax(jnp.einsum('bhqd,bhkd->bhqk', qa, k1, preferred_element_type=F32) * scale + bias, axis=-1)
        p2 = jax.nn.softmax(jnp.einsum('bhqd,bhkd->bhqk', qb, k2, preferred_element_type=F32) * scale + bias, axis=-1)
        return jnp.einsum('bhqk,bhkd->bhqd', (p1 - lam * p2).astype(v.dtype), v)

    return sweep_blocks(block, S)


def gqa_attention(q, k, v):
    b, n, g, S, d = q.shape
    scale = d ** -0.5

    def block(i):
        qb = lax.dynamic_slice_in_dim(q, i * Q_BLOCK, Q_BLOCK, axis=3)
        s = jnp.einsum('bngqd,bnkd->bngqk', qb, k, preferred_element_type=F32) * scale
        p = jax.nn.softmax(s, axis=-1)
        o = jnp.einsum('bngqk,bnkd->bngqd', p.astype(v.dtype), v)
        return o.reshape(b, n * g, Q_BLOCK, d)

    return sweep_blocks(block, S)


def mla_attention(q_nope, q_rope, k_nope, k_rope, v):
    S = q_nope.shape[2]
    scale = (C_NOPE + C_ROPE) ** -0.5

    def block(i):
        s0 = i * Q_BLOCK
        qn = lax.dynamic_slice_in_dim(q_nope, s0, Q_BLOCK, axis=2)
        qr = lax.dynamic_slice_in_dim(q_rope, s0, Q_BLOCK, axis=2)
        s = (jnp.einsum('bhqd,bhkd->bhqk', qn, k_nope, preferred_element_type=F32)
             + jnp.einsum('bhqr,bkr->bhqk', qr, k_rope, preferred_element_type=F32)) * scale
        p = jax.nn.softmax(s, axis=-1)
        return jnp.einsum('bhqk,bhkd->bhqd', p.astype(v.dtype), v)

    return sweep_blocks(block, S)


def memory_attention(h, m, w_q, w_kv, w_out):
    b, S, _ = h.shape
    M = m.shape[1]
    q = (h @ w_q).reshape(b, S, X_HEADS, X_DIM)
    kv = (m @ w_kv).reshape(b, M, 2, X_HEADS, X_DIM)
    k, v = kv[:, :, 0], kv[:, :, 1]
    s = jnp.einsum('bqhd,bkhd->bhqk', q, k, preferred_element_type=F32) * X_DIM ** -0.5
    p = jax.nn.softmax(s, axis=-1)
    o = jnp.einsum('bhqk,bkhd->bqhd', p.astype(v.dtype), v).reshape(b, S, X_HEADS * X_DIM)
    return o @ w_out


def _trunk(x, mem, rel_bias, g_mix_pre, g_mix_post, w_in, lam_q1, lam_k1, lam_q2, lam_k2, g_a_out,
           g_b_q, g_b_k, g_c_q, g_c_kv, w_c_q_up, w_c_kv_up, w_br_a, w_br_b, w_br_c, w_mix_out,
           g_x_pre, g_x_post, g_mem, w_x_q, w_x_kv, w_x_out,
           g_ffn_pre, g_ffn_post, w_ffn_gate, w_ffn_up, w_ffn_down):
    b, S, _ = x.shape
    rows = S // GRID_W
    rr, cc = jnp.meshgrid(jnp.arange(rows), jnp.arange(GRID_W), indexing='ij')
    row_pos, col_pos = rr.reshape(-1), cc.reshape(-1)
    tok_pos = jnp.arange(S)
    split_points = [int(v) for v in np.cumsum(IN_SIZES)[:-1]]
    for l in range(DEPTH):
        h = rms_norm(x, g_mix_pre[l])
        z = h @ w_in[l]
        a_q, a_k, a_v, b_q, b_k, b_v, c_qa, c_kva, c_kr, gates = jnp.split(z, split_points, axis=-1)

        lam_init = 0.8 - 0.6 * math.exp(-0.3 * l)
        lam = (jnp.exp(jnp.sum(lam_q1[l].astype(F32) * lam_k1[l].astype(F32)))
               - jnp.exp(jnp.sum(lam_q2[l].astype(F32) * lam_k2[l].astype(F32))) + lam_init)
        qa = a_q.reshape(b, S, A_HEADS, 2, A_QK_DIM).transpose(3, 0, 2, 1, 4)
        ka = a_k.reshape(b, S, A_HEADS, 2, A_QK_DIM).transpose(3, 0, 2, 1, 4)
        va = a_v.reshape(b, S, A_HEADS, A_V_DIM).transpose(0, 2, 1, 3)
        oa = diff_attention(qa[0], qa[1], ka[0], ka[1], va, rel_bias, lam)
        oa = (rms_norm(oa, g_a_out[l]) * (1.0 - lam_init)).reshape(b, S, A_OUT)

        qb = rms_norm(b_q.reshape(b, S, B_Q_HEADS, B_DIM), g_b_q[l]).transpose(0, 2, 1, 3)
        kb = rms_norm(b_k.reshape(b, S, B_KV_HEADS, B_DIM), g_b_k[l]).transpose(0, 2, 1, 3)
        vb = b_v.reshape(b, S, B_KV_HEADS, B_DIM).transpose(0, 2, 1, 3)
        qb = axial_rope(qb, row_pos, col_pos)
        kb = axial_rope(kb, row_pos, col_pos)
        ob = gqa_attention(qb.reshape(b, B_KV_HEADS, B_GROUP, S, B_DIM), kb, vb).reshape(b, S, B_OUT)

        cq = (rms_norm(c_qa, g_c_q[l]) @ w_c_q_up[l]).reshape(b, S, C_HEADS, C_NOPE + C_ROPE).transpose(0, 2, 1, 3)
        q_nope, q_rope = cq[..., :C_NOPE], rope(cq[..., C_NOPE:], tok_pos)
        ckv = (rms_norm(c_kva, g_c_kv[l]) @ w_c_kv_up[l]).reshape(b, S, C_HEADS, C_NOPE + C_V).transpose(0, 2, 1, 3)
        k_nope, vc = ckv[..., :C_NOPE], ckv[..., C_NOPE:]
        k_rope = rope(c_kr, tok_pos)
        oc = mla_attention(q_nope, q_rope, k_nope, k_rope, vc).reshape(b, S, C_OUT)

        g = jax.nn.sigmoid(gates.astype(F32)).astype(x.dtype).reshape(b, S, N_BRANCH, D_MODEL)
        merged = (g[:, :, 0] * (oa @ w_br_a[l]) + g[:, :, 1] * (ob @ w_br_b[l])
                  + g[:, :, 2] * (oc @ w_br_c[l]))
        x = x + rms_norm(merged @ w_mix_out[l], g_mix_post[l])

        h = rms_norm(x, g_x_pre[l])
        xo = memory_attention(h, rms_norm(mem, g_mem[l]), w_x_q[l], w_x_kv[l], w_x_out[l])
        x = x + rms_norm(xo, g_x_post[l])

        h = rms_norm(x, g_ffn_pre[l])
        f = (jax.nn.silu(h @ w_ffn_gate[l]) * (h @ w_ffn_up[l])) @ w_ffn_down[l]
        x = x + rms_norm(f, g_ffn_post[l])
    return x


def setup_inputs(seed: int = 0) -> dict:
    key = jax.random.key(seed)
    ks = iter(jax.random.split(key, 40))

    def nrm(shape, scale):
        return jax.random.normal(next(ks), shape, F32) * scale

    def gain(shape):
        return 1.0 + 0.02 * jax.random.normal(next(ks), shape, F32)

    L, D = DEPTH, D_MODEL
    return {
        "x_prompt": nrm((BATCH, SEQ, D), 1.0),
        "x_sample": nrm((DEC_BATCH, DEC_SEQ, D), 1.0),
        "mem_prompt": nrm((BATCH, MEM_TOKENS, D), 1.0),
        "mem_sample": nrm((DEC_BATCH, MEM_TOKENS, D), 1.0),
        "rel_bias": nrm((NUM_BUCKETS, A_HEADS), 0.5),
        "g_mix_pre": gain((L, D)),
        "g_mix_post": gain((L, D)),
        "w_in": nrm((L, D, IN_COLS), D ** -0.5),
        "lam_q1": nrm((L, A_QK_DIM), 0.1),
        "lam_k1": nrm((L, A_QK_DIM), 0.1),
        "lam_q2": nrm((L, A_QK_DIM), 0.1),
        "lam_k2": nrm((L, A_QK_DIM), 0.1),
        "g_a_out": gain((L, A_V_DIM)),
        "g_b_q": gain((L, B_DIM)),
        "g_b_k": gain((L, B_DIM)),
        "g_c_q": gain((L, C_Q_RANK)),
        "g_c_kv": gain((L, C_KV_RANK)),
        "w_c_q_up": nrm((L, C_Q_RANK, C_HEADS * (C_NOPE + C_ROPE)), C_Q_RANK ** -0.5),
        "w_c_kv_up": nrm((L, C_KV_RANK, C_HEADS * (C_NOPE + C_V)), C_KV_RANK ** -0.5),
        "w_br_a": nrm((L, A_OUT, D), A_OUT ** -0.5),
        "w_br_b": nrm((L, B_OUT, D), B_OUT ** -0.5),
        "w_br_c": nrm((L, C_OUT, D), C_OUT ** -0.5),
        "w_mix_out": nrm((L, D, D), D ** -0.5),
        "g_x_pre": gain((L, D)),
        "g_x_post": gain((L, D)),
        "g_mem": gain((L, D)),
        "w_x_q": nrm((L, D, X_HEADS * X_DIM), D ** -0.5),
        "w_x_kv": nrm((L, D, 2 * X_HEADS * X_DIM), D ** -0.5),
        "w_x_out": nrm((L, X_HEADS * X_DIM, D), (X_HEADS * X_DIM) ** -0.5),
        "g_ffn_pre": gain((L, D)),
        "g_ffn_post": gain((L, D)),
        "w_ffn_gate": nrm((L, D, D_FF), D ** -0.5),
        "w_ffn_up": nrm((L, D, D_FF), D ** -0.5),
        "w_ffn_down": nrm((L, D_FF, D), D_FF ** -0.5),
    }


def reference(x_prompt, x_sample, mem_prompt, mem_sample, rel_bias, g_mix_pre, g_mix_post, w_in,
              lam_q1, lam_k1, lam_q2, lam_k2, g_a_out, g_b_q, g_b_k, g_c_q, g_c_kv, w_c_q_up, w_c_kv_up,
              w_br_a, w_br_b, w_br_c, w_mix_out, g_x_pre, g_x_post, g_mem, w_x_q, w_x_kv, w_x_out,
              g_ffn_pre, g_ffn_post, w_ffn_gate, w_ffn_up, w_ffn_down):
    weights = (rel_bias, g_mix_pre, g_mix_post, w_in, lam_q1, lam_k1, lam_q2, lam_k2, g_a_out,
               g_b_q, g_b_k, g_c_q, g_c_kv, w_c_q_up, w_c_kv_up, w_br_a, w_br_b, w_br_c, w_mix_out,
               g_x_pre, g_x_post, g_mem, w_x_q, w_x_kv, w_x_out,
               g_ffn_pre, g_ffn_post, w_ffn_gate, w_ffn_up, w_ffn_down)
    y_prompt = _trunk(x_prompt, mem_prompt, *weights)
    y_sample = _trunk(x_sample, mem_sample, *weights)
    return (y_prompt, y_sample)
```

```cpp
#include <hip/hip_runtime.h>
#include <hip/hip_cooperative_groups.h>
#include <cstdio>
#include <cstdint>
#include <type_traits>
namespace cg = cooperative_groups;

#ifndef REP_MASK
#define REP_MASK 0
#endif
#ifndef ATT_DMA
#define ATT_DMA 1
#endif
#ifndef NQR_C
#define NQR_C 4
#endif
#ifndef PIPE2_MODES
#define PIPE2_MODES 0
#endif
#ifndef ONE_LAUNCH
#define ONE_LAUNCH 1
#endif

typedef unsigned short bf16_t;
typedef short bf16x8 __attribute__((ext_vector_type(8)));
typedef short s16x4 __attribute__((ext_vector_type(4)));
typedef float f32x2 __attribute__((ext_vector_type(2)));
typedef float f32x4 __attribute__((ext_vector_type(4)));
typedef float f32x16 __attribute__((ext_vector_type(16)));
typedef unsigned u32x2 __attribute__((ext_vector_type(2)));
typedef unsigned u32x4 __attribute__((ext_vector_type(4)));
#define LAS __attribute__((address_space(3)))
#define DI __device__ __forceinline__

constexpr int T = 16384, DM = 2048, LDZ = 11776, NIN = 11584, DFF = 5632, NLAYER = 2;
constexpr int ZC_AQ = 0, ZC_AK = 1024, ZC_AV = 2048, ZC_BQ = 3072, ZC_BK = 4096, ZC_BV = 4352, ZC_CQA = 4608, ZC_CKVA = 5120, ZC_CKR = 5376, ZC_G = 5440;
constexpr float EPS = 1e-6f, LOG2E = 1.4426950408889634f;
constexpr int NTHR = 512;
constexpr int LDS_BYTES = 152064 + 512;
constexpr int NOSIG = 0x7fffffff;

constexpr size_t W1_IN = 0;
constexpr size_t W1_CQ = W1_IN + (size_t)LDZ * 2048 * 2;
constexpr size_t W1_CKV = W1_CQ + (size_t)1536 * 512 * 2;
constexpr size_t W1_BR = W1_CKV + (size_t)2048 * 256 * 2;
constexpr size_t W1_MIX = W1_BR + (size_t)3 * 2048 * 1024 * 2;
constexpr size_t W1_XQ = W1_MIX + (size_t)2048 * 2048 * 2;
constexpr size_t W1_XKV = W1_XQ + (size_t)512 * 2048 * 2;
constexpr size_t W1_XOUT = W1_XKV + (size_t)1024 * 2048 * 2;
constexpr size_t W1_END = W1_XOUT + (size_t)2048 * 512 * 2;
constexpr size_t WS_Z = W1_END;
constexpr size_t WS_XQ = WS_Z, WS_XATT = WS_Z + (size_t)T * 512 * 2, WS_U = WS_Z;
constexpr size_t WS_H = WS_Z + (size_t)T * LDZ * 2;
constexpr size_t WS_O = WS_H + (size_t)T * 2048 * 2;
constexpr size_t WS_TMP = WS_O;
constexpr size_t W2_GU = WS_O + (size_t)T * 2048 * 2;
constexpr size_t W2_DN = W2_GU + (size_t)11264 * 2048 * 2;
constexpr size_t WS_CQ = WS_O + (size_t)T * 3072 * 2;
constexpr size_t WS_OEND = WS_CQ + (size_t)T * 1536 * 2;
static_assert(W2_DN + (size_t)2048 * 5632 * 2 <= WS_OEND, "W2 fits");
constexpr size_t WS_ROPE = WS_OEND;
constexpr size_t WS_MEMN = WS_ROPE + (size_t)8192 * 32 * 8;
constexpr size_t WS_MEMKV = WS_MEMN + (size_t)768 * 2048 * 2;
constexpr size_t WS_CTL = WS_MEMKV + (size_t)768 * 1024 * 2;
constexpr size_t WS_XB = WS_CTL + 256;
constexpr size_t WS_END = WS_XB + 16384;

struct KArgs { const float* in[34]; float* out; unsigned char* ws; };
struct Params {
    LAS const unsigned long long* t; int tid;
    DI unsigned long long ld(int i) const { const unsigned long long v = t[i]; const unsigned lo = __builtin_amdgcn_readfirstlane((unsigned)v), hi = __builtin_amdgcn_readfirstlane((unsigned)(v >> 32)); return ((unsigned long long)hi << 32) | lo; }
    DI void* gp(int i) const { return (void*)(__attribute__((address_space(1))) void*)ld(i); }
    DI const float* in(int i) const { return (const float*)gp(i); }
    DI float* out() const { return (float*)gp(34); }
    DI unsigned char* ws() const { return (unsigned char*)gp(35); }
};
constexpr int PTAB_OFF = 152064;

DI unsigned cvtpk(float lo, float hi) { unsigned r; asm volatile("v_cvt_pk_bf16_f32 %0, %1, %2" : "=v"(r) : "v"(lo), "v"(hi)); return r; }
DI float bf2f(unsigned short b) { return __uint_as_float(((unsigned)b) << 16); }
DI float bflo(unsigned w) { return __uint_as_float(w << 16); }
DI float bfhi(unsigned w) { return __uint_as_float(w & 0xffff0000u); }
DI unsigned short f2bf(float f) { return (unsigned short)(cvtpk(f, f) & 0xffffu); }
template <int M> DI float sx(float v) { return __int_as_float(__builtin_amdgcn_ds_swizzle(__float_as_int(v), (M << 10) | 0x1f)); }
DI float half_sum(float v) { v += sx<16>(v); v += sx<8>(v); v += sx<4>(v); v += sx<2>(v); v += sx<1>(v); return v; }
DI float wave_sum(float v) { v = half_sum(v); auto rr = __builtin_amdgcn_permlane32_swap(__float_as_uint(v), __float_as_uint(v), false, false); return __uint_as_float(rr[0]) + __uint_as_float(rr[1]); }
DI float fsigmoid(float x) { return __builtin_amdgcn_rcpf(1.f + __expf(-x)); }
DI int fresh_tid(const Params& P) { int t = P.tid; asm volatile("" : "+v"(t)); return t; }
DI const float* xin_row(const Params& P, int t) { return t < 8192 ? P.in(0) + (size_t)t * DM : P.in(1) + (size_t)(t - 8192) * DM; }

namespace pg8 {
constexpr int BM = 256, BK = 64, HALF = 128, HTB = HALF * BK * 2, STAGE_BYTES = 8 * HTB, NXCD = 8, WGM = 8;
DI int lds_byte(int r, int c) { const int st = (r >> 4) * 2 + (c >> 5), rr = r & 15, cc = c & 31, ob = rr * 64 + cc * 2; return st * 1024 + (ob ^ (((ob >> 9) & 1) << 5)); }
DI void stage_rc(int b, int& R, int& C) { const int st = b / 1024, sb = b % 1024, swz = sb ^ (((sb >> 9) & 1) << 5); R = (st >> 1) * 16 + swz / 64; C = (st & 1) * 32 + (swz % 64) / 2; }
DI int perm32(int rho) { const int n = rho >> 4, i = rho & 15; return 8 * (i >> 2) + 4 * n + (i & 3); }

struct Unit { int pm, pn, seg; };
struct Gemm { const bf16_t* A; const bf16_t* Bt; int M, N, K, lda, nseg; long segA, segB; };

struct Order {
    int nM, nN, nwg, G, c, nseg;
    DI void init(int M, int N, int nseg_, int G_, int c_) { nM = M / BM; nN = N / BM; nwg = nM * nN; G = G_; c = c_; nseg = nseg_; }
    DI bool next(int i, Unit& u) const {
        const int rd = i / nseg; u.seg = i - rd * nseg;
        const long L = (long)rd * G + c; if (L >= nwg) return false;
        int wgid = (int)L; { const int q = nwg / NXCD, r = nwg % NXCD, xcd = wgid % NXCD, off = wgid / NXCD; wgid = (xcd < r ? xcd * (q + 1) : r * (q + 1) + (xcd - r) * q) + off; }
        const int nig = WGM * nN, gid = wgid / nig, fm = gid * WGM, gsz = (nM - fm) < WGM ? (nM - fm) : WGM;
        u.pm = fm + ((wgid % nig) % gsz); u.pn = (wgid % nig) / gsz; return true;
    }
};

template <class Epi>
DI void gemm_phase(LAS unsigned char* lds, const Gemm g, const Order& S, const Epi& E, const int tid) {
    const int wid = __builtin_amdgcn_readfirstlane(tid >> 6), lane = tid & 63, wr = wid >> 2, wc = wid & 3, fr = lane & 15, fq = lane >> 4;
    const int K = g.K, nt = K / BK;
    unsigned voffA[2], voffB[2];
#pragma unroll
    for (int i = 0; i < 2; ++i) { int R, C; stage_rc(tid * 16 + i * 8192, R, C); const int Rb = (R & ~31) + perm32(R & 31);
        voffA[i] = (unsigned)(R * g.lda + C) * 2u; voffB[i] = (unsigned)(Rb * K + C) * 2u; }
    const size_t kstep = (size_t)(BK * 2);
    const size_t hstepA = (size_t)HALF * g.lda * 2, hstepB = (size_t)HALF * K * 2;
    const size_t tstepA = 2 * hstepA, tstepB = 2 * hstepB;
    const unsigned ldsw = (unsigned)wid * 1024u;
    const int aoff = lds_byte(wr * 64 + fr, fq * 8), boff = lds_byte(wc * 32 + fr, fq * 8);
#define PG8_SA(b, h) (((b) * 2 + (h)) * HTB)
#define PG8_SB(b, h) ((4 + (b) * 2 + (h)) * HTB)
#define PG8_STAGE(bufoff, gbase, voff) do { _Pragma("unroll") for (int _i = 0; _i < 2; ++_i) \
        __builtin_amdgcn_global_load_lds((const unsigned*)((const char*)(gbase) + (voff)[_i]), (LAS unsigned*)(lds + (bufoff) + ldsw + _i * 8192), 16, 0, 0); } while (0)
#define PG8_LDA(dst, b, h) do { _Pragma("unroll") for (int m = 0; m < 4; ++m) _Pragma("unroll") for (int k = 0; k < 2; ++k) dst[m][k] = *(const LAS bf16x8*)(lds + PG8_SA(b, h) + aoff + m * 2048 + k * 1024); } while (0)
#define PG8_LDB(dst, b, h) do { _Pragma("unroll") for (int n = 0; n < 2; ++n) _Pragma("unroll") for (int k = 0; k < 2; ++k) dst[n][k] = *(const LAS bf16x8*)(lds + PG8_SB(b, h) + boff + n * 2048 + k * 1024); } while (0)
#define PG8_MMA(ai, bj, At, Bt) do { __builtin_amdgcn_s_setprio(1); _Pragma("unroll") for (int m = 0; m < 4; ++m) _Pragma("unroll") for (int n = 0; n < 2; ++n) _Pragma("unroll") for (int k = 0; k < 2; ++k) \
        acc[ai][bj][m][n] = __builtin_amdgcn_mfma_f32_16x16x32_bf16(Bt[n][k], At[m][k], acc[ai][bj][m][n], 0, 0, 0); __builtin_amdgcn_s_setprio(0); } while (0)
#define PG8_WAIT_V(n) asm volatile("s_waitcnt vmcnt(" #n ")" ::: "memory")
#define PG8_WAIT_L(n) asm volatile("s_waitcnt lgkmcnt(" #n ")" ::: "memory")
#define PG8_BAR __builtin_amdgcn_s_barrier()
#define PG8_SCHED __builtin_amdgcn_sched_barrier(0)
    Unit cur, nxt; int ui = 0;
    if (!S.next(0, cur)) return;
    f32x4 acc[2][2][4][2];
#pragma unroll
    for (int a = 0; a < 2; ++a)
#pragma unroll
        for (int b = 0; b < 2; ++b)
#pragma unroll
            for (int m = 0; m < 4; ++m)
#pragma unroll
                for (int n = 0; n < 2; ++n) acc[a][b][m][n] = (f32x4){0.f, 0.f, 0.f, 0.f};
    bf16x8 At[4][2], B0[2][2], B1[2][2];
    const char* cA = (const char*)(g.A + cur.seg * g.segA) + (size_t)cur.pm * tstepA; const char* cB = (const char*)(g.Bt + cur.seg * g.segB) + (size_t)cur.pn * tstepB;
    PG8_STAGE(PG8_SB(0, 0), cB, voffB); PG8_STAGE(PG8_SA(0, 0), cA, voffA); PG8_STAGE(PG8_SB(0, 1), cB + hstepB, voffB); PG8_STAGE(PG8_SA(0, 1), cA + hstepA, voffA);
    if (wr == 1) PG8_BAR;
    PG8_WAIT_V(4); PG8_BAR;
    PG8_STAGE(PG8_SB(1, 0), cB + kstep, voffB); PG8_STAGE(PG8_SA(1, 0), cA + kstep, voffA); PG8_STAGE(PG8_SB(1, 1), cB + hstepB + kstep, voffB);
    PG8_WAIT_V(6); PG8_BAR;
    for (;;) {
        const bool has_next = S.next(ui + 1, nxt);
        const char* nA = has_next ? (const char*)(g.A + nxt.seg * g.segA) + (size_t)nxt.pm * tstepA : cA;
        const char* nB = has_next ? (const char*)(g.Bt + nxt.seg * g.segB) + (size_t)nxt.pn * tstepB : cB;
        for (int t = 0; t < nt; t += 2) {
            const bool last = (t == nt - 2);
            const char* a1 = cA + (size_t)(t + 1) * kstep;
            const char* a2 = last ? nA : cA + (size_t)(t + 2) * kstep; const char* b2 = last ? nB : cB + (size_t)(t + 2) * kstep;
            const char* a3 = a2 + kstep; const char* b3 = b2 + kstep;
            PG8_LDB(B0, 0, 0); PG8_SCHED; PG8_LDA(At, 0, 0); PG8_STAGE(PG8_SA(1, 1), a1 + hstepA, voffA);
            PG8_WAIT_L(8); PG8_BAR; PG8_WAIT_L(0); PG8_MMA(0, 0, At, B0); PG8_BAR; PG8_SCHED;
            PG8_LDB(B1, 0, 1); PG8_STAGE(PG8_SB(0, 0), b2, voffB);
            PG8_BAR; PG8_WAIT_L(0); PG8_MMA(0, 1, At, B1); PG8_BAR;
            PG8_LDA(At, 0, 1); PG8_STAGE(PG8_SA(0, 0), a2, voffA);
            PG8_BAR; PG8_WAIT_L(0); PG8_MMA(1, 0, At, B0); PG8_BAR; PG8_SCHED;
            PG8_STAGE(PG8_SB(0, 1), b2 + hstepB, voffB);
            PG8_WAIT_V(6); PG8_BAR; PG8_MMA(1, 1, At, B1); PG8_BAR;
            PG8_LDB(B0, 1, 0); PG8_SCHED; PG8_LDA(At, 1, 0); PG8_STAGE(PG8_SA(0, 1), a2 + hstepA, voffA);
            PG8_WAIT_L(8); PG8_BAR; PG8_WAIT_L(0); PG8_MMA(0, 0, At, B0); PG8_BAR; PG8_SCHED;
            PG8_LDB(B1, 1, 1); PG8_STAGE(PG8_SB(1, 0), b3, voffB);
            PG8_BAR; PG8_WAIT_L(0); PG8_MMA(0, 1, At, B1); PG8_BAR;
            PG8_LDA(At, 1, 1); PG8_STAGE(PG8_SA(1, 0), a3, voffA);
            PG8_BAR; PG8_WAIT_L(0); PG8_MMA(1, 0, At, B0); PG8_BAR; PG8_SCHED;
            PG8_STAGE(PG8_SB(1, 1), b3 + hstepB, voffB);
            PG8_WAIT_V(6); PG8_BAR; PG8_MMA(1, 1, At, B1); PG8_BAR;
        }
        E(acc, cur, wr, wc, fr, fq);
        if (!has_next) break;
#pragma unroll
        for (int a = 0; a < 2; ++a)
#pragma unroll
            for (int b = 0; b < 2; ++b)
#pragma unroll
                for (int m = 0; m < 4; ++m)
#pragma unroll
                    for (int n = 0; n < 2; ++n) acc[a][b][m][n] = (f32x4){0.f, 0.f, 0.f, 0.f};
        cur = nxt; cA = nA; cB = nB; ++ui;
    }
    PG8_WAIT_V(0);
    if (wr == 0) PG8_BAR;
    PG8_BAR;
#undef PG8_SA
#undef PG8_SB
#undef PG8_STAGE
#undef PG8_LDA
#undef PG8_LDB
#undef PG8_MMA
#undef PG8_WAIT_V
#undef PG8_WAIT_L
#undef PG8_BAR
#undef PG8_SCHED
}

DI u32x4 pack8(f32x4 v0, f32x4 v1) { u32x4 w; w.x = cvtpk(v0[0], v0[1]); w.y = cvtpk(v0[2], v0[3]); w.z = cvtpk(v1[0], v1[1]); w.w = cvtpk(v1[2], v1[3]); return w; }
struct EpiAny {
    int mode; bf16_t* O; int ldc; int sigc; const bf16_t* Z;
    DI void operator()(const f32x4 (&acc)[2][2][4][2], const Unit& u, int wr, int wc, int fr, int fq) const {
        const int row0 = u.pm * BM + wr * 64 + fr;
        if (mode == 0) {
            const int col0 = u.pn * BM + wc * 32 + 8 * fq;
#pragma unroll
            for (int ai = 0; ai < 2; ++ai)
#pragma unroll
                for (int m = 0; m < 4; ++m) { bf16_t* rowp = O + (size_t)(row0 + ai * HALF + m * 16) * ldc + col0;
#pragma unroll
                    for (int bj = 0; bj < 2; ++bj) { f32x4 v0 = acc[ai][bj][m][0], v1 = acc[ai][bj][m][1];
                        if (col0 + bj * HALF >= sigc) {
#pragma unroll
                            for (int j = 0; j < 4; ++j) { v0[j] = fsigmoid(v0[j]); v1[j] = fsigmoid(v1[j]); } }
                        *(u32x4*)(rowp + bj * HALF) = pack8(v0, v1); } }
        } else if (mode == 1) {
            const int col0 = u.pn * HALF + wc * 32 + 8 * fq;
#pragma unroll
            for (int ai = 0; ai < 2; ++ai)
#pragma unroll
                for (int m = 0; m < 4; ++m) { bf16_t* rowp = O + (size_t)(row0 + ai * HALF + m * 16) * ldc + col0;
                    f32x4 v0, v1;
#pragma unroll
                    for (int j = 0; j < 4; ++j) { const float g0 = acc[ai][0][m][0][j], g1 = acc[ai][0][m][1][j];
                        v0[j] = g0 * fsigmoid(g0) * acc[ai][1][m][0][j]; v1[j] = g1 * fsigmoid(g1) * acc[ai][1][m][1][j]; }
                    *(u32x4*)rowp = pack8(v0, v1); }
        } else {
            const int col0 = u.pn * BM + wc * 32 + 8 * fq;
#pragma unroll
            for (int ai = 0; ai < 2; ++ai)
#pragma unroll
                for (int m = 0; m < 4; ++m) { const int row = row0 + ai * HALF + m * 16; bf16_t* rowp = O + (size_t)row * DM + col0;
                    const bf16_t* gp = Z + (size_t)row * LDZ + ZC_G + u.seg * DM + col0;
#pragma unroll
                    for (int bj = 0; bj < 2; ++bj) { const u32x4 gw = *(const u32x4*)(gp + bj * HALF);
                        f32x4 v0 = acc[ai][bj][m][0], v1 = acc[ai][bj][m][1];
                        v0[0] *= bflo(gw.x); v0[1] *= bfhi(gw.x); v0[2] *= bflo(gw.y); v0[3] *= bfhi(gw.y);
                        v1[0] *= bflo(gw.z); v1[1] *= bfhi(gw.z); v1[2] *= bflo(gw.w); v1[3] *= bfhi(gw.w);
                        if (u.seg > 0) { const u32x4 pw = *(const u32x4*)(rowp + bj * HALF);
                            v0[0] += bflo(pw.x); v0[1] += bfhi(pw.x); v0[2] += bflo(pw.y); v0[3] += bfhi(pw.y);
                            v1[0] += bflo(pw.z); v1[1] += bfhi(pw.z); v1[2] += bflo(pw.w); v1[3] += bfhi(pw.w); }
                        *(u32x4*)(rowp + bj * HALF) = pack8(v0, v1); } }
        }
    }
};
}

struct GD { const bf16_t* A; const bf16_t* Bt; bf16_t* O; const bf16_t* Z; int lda, M, N, K, ldc, sigc, mode, nseg, coff; long segA, segB; };
DI void gd_set(GD& d, const bf16_t* A, int lda, const bf16_t* Bt, int M, int N, int K, bf16_t* O, int ldc, int mode = 0, int sigc = NOSIG) {
    d.A = A; d.lda = lda; d.Bt = Bt; d.M = M; d.N = N; d.K = K; d.O = O; d.ldc = ldc; d.mode = mode; d.sigc = sigc; d.nseg = 1; d.segA = 0; d.segB = 0; d.Z = nullptr; d.coff = 0; }
DI void run_gemm(const int tid, unsigned char* shm, const GD& d) {
    pg8::Gemm g; g.A = d.A; g.Bt = d.Bt; g.M = d.M; g.N = d.N; g.K = d.K; g.lda = d.lda; g.nseg = d.nseg; g.segA = d.segA; g.segB = d.segB;
    pg8::EpiAny E; E.mode = d.mode; E.O = d.O; E.ldc = d.ldc; E.sigc = d.sigc; E.Z = d.Z;
    pg8::Order S; S.init(d.M, d.N, d.nseg, (int)gridDim.x, (int)((blockIdx.x + d.coff) % gridDim.x));
    pg8::gemm_phase<pg8::EpiAny>((LAS unsigned char*)shm, g, S, E, tid);
}

#define SBAR() __builtin_amdgcn_sched_barrier(0)
DI int crow(int r, int hi) { return (r & 3) + 8 * (r >> 2) + 4 * hi; }
DI int v_st(int k, int c) { const int kk = (k & ~0xC) | ((k & 4) << 1) | ((k & 8) >> 1); return ((kk >> 3) * 4 + (c >> 5)) * 512 + ((kk & 7) * 32 + (c & 31)) * 2; }
DI int v_rd_base(int lane) { return ((lane & 3) << 3) | (((lane >> 2) & 3) << 6) | (((lane >> 4) & 1) << 5) | (((lane >> 5) & 1) << 8); }
constexpr int v_rd_off(int d0, int ks, int half) { return d0 * 512 + ks * 4096 + half * 2048; }
template <int OFF> DI s16x4 tr_read(int vb) { s16x4 r; asm volatile("ds_read_b64_tr_b16 %0, %1 offset:%2" : "=&v"(r) : "v"(vb), "i"(OFF) : "memory"); return r; }
template <int I, int N, class F> DI void cfor(F&& f) { if constexpr (I < N) { f(std::integral_constant<int, I>{}); cfor<I + 1, N>(f); } }
template <int OFF> DI void dsr128(bf16x8& r, int addr) { asm volatile("ds_read_b128 %0, %1 offset:%2" : "=&v"(r) : "v"(addr), "i"(OFF) : "memory"); }
template <int N> DI void wait_lgkm() { asm volatile("s_waitcnt lgkmcnt(%0)" :: "i"(N) : "memory"); }
template <int KS> DI void v_rd8(s16x4* f, int vb) {
    f[0] = tr_read<v_rd_off(0, KS, 0)>(vb); f[1] = tr_read<v_rd_off(0, KS, 1)>(vb); f[2] = tr_read<v_rd_off(1, KS, 0)>(vb); f[3] = tr_read<v_rd_off(1, KS, 1)>(vb);
    f[4] = tr_read<v_rd_off(2, KS, 0)>(vb); f[5] = tr_read<v_rd_off(2, KS, 1)>(vb); f[6] = tr_read<v_rd_off(3, KS, 0)>(vb); f[7] = tr_read<v_rd_off(3, KS, 1)>(vb);
}
DI void pv_mm(f32x16* o, const s16x4* f, bf16x8 pa) {
#define PK(L, H) (bf16x8){L[0], L[1], L[2], L[3], H[0], H[1], H[2], H[3]}
    o[0] = __builtin_amdgcn_mfma_f32_32x32x16_bf16(pa, PK(f[0], f[1]), o[0], 0, 0, 0);
    o[1] = __builtin_amdgcn_mfma_f32_32x32x16_bf16(pa, PK(f[2], f[3]), o[1], 0, 0, 0);
    o[2] = __builtin_amdgcn_mfma_f32_32x32x16_bf16(pa, PK(f[4], f[5]), o[2], 0, 0, 0);
    o[3] = __builtin_amdgcn_mfma_f32_32x32x16_bf16(pa, PK(f[6], f[7]), o[3], 0, 0, 0);
#undef PK
}
DI void pv_d0(f32x16* o, int vb, bf16x8 pa0, bf16x8 pa1, bf16x8 pa2, bf16x8 pa3) {
    s16x4 fa[8], fb[8];
    v_rd8<0>(fa, vb);
    v_rd8<1>(fb, vb); wait_lgkm<8>(); SBAR(); pv_mm(o, fa, pa0);
    v_rd8<2>(fa, vb); wait_lgkm<8>(); SBAR(); pv_mm(o, fb, pa1);
    v_rd8<3>(fb, vb); wait_lgkm<8>(); SBAR(); pv_mm(o, fa, pa2);
    wait_lgkm<0>(); SBAR(); pv_mm(o, fb, pa3);
}

DI void pv_d0_s(f32x16* o, int vb, bf16x8 pa0, bf16x8 pa1, bf16x8 pa2, bf16x8 pa3) {
    s16x4 fa[8];
    v_rd8<0>(fa, vb); wait_lgkm<0>(); SBAR(); pv_mm(o, fa, pa0); SBAR();
    v_rd8<1>(fa, vb); wait_lgkm<0>(); SBAR(); pv_mm(o, fa, pa1); SBAR();
    v_rd8<2>(fa, vb); wait_lgkm<0>(); SBAR(); pv_mm(o, fa, pa2); SBAR();
    v_rd8<3>(fa, vb); wait_lgkm<0>(); SBAR(); pv_mm(o, fa, pa3);
}
struct AttnArgs {
    const bf16_t* Q; int ldq;
    const bf16_t* K; int ldk;
    const bf16_t* K2; int ldk2;
    const bf16_t* V; int ldv;
    bf16_t* O; int ldo;
    int seq; float C;
    int qpos0;
    const float* tab;
    const f32x2* rope;
    int map; float lam; const float* ga; float oscale;
    int tid;
};

constexpr float THR_L2 = 8.f * LOG2E;
constexpr int ATT_QR = 86016;
constexpr int ATT_WSC = 2 * 16384 + 2 * 64 * 384;

template <int DQK, int MODE>
DI void attn_body(const AttnArgs& a, char* lds) {
    constexpr int KROWB = DQK * 2, SHM_K = 64 * KROWB, SHM_V = 64 * 128 * 2, KCH = DQK / 64, CPR = DQK / 8, ND0 = DQK / 16, SD = 1;
    int tid = a.tid; asm volatile("" : "+v"(tid));
    const int wid = tid >> 6, lane = tid & 63, r32 = lane & 31, hi = lane >> 5;
    char* V_lds = lds; char* K_lds = lds + 2 * SHM_V;
    float* wsc = (float*)(lds + ATT_WSC) + wid * 64; float* li_l = wsc; float* al_l = wsc + 32;
    constexpr int NQR = (MODE == 2) ? NQR_C : ND0;
    float m_reg = -1e30f, l_reg = 0; f32x16 o[4] = {}; bf16x8 qr[NQR];
    char* qrl = lds + ATT_QR + wid * ((12 - NQR_C) * 1024) + lane * 16;
    const float C = a.C;
    auto ksw = [](int row) { return KROWB == 256 ? (((row & 7) | (((row >> 4) & 1) << 3)) << 4) : (((row >> 1) & 7) << 4); };
    __syncthreads();
    const bf16_t* Qw = a.Q + (size_t)(wid * 32 + r32) * a.ldq + hi * 8;
#pragma unroll
    for (int d0 = 0; d0 < NQR; ++d0) qr[d0] = *(const bf16x8*)(Qw + d0 * 16);
    if constexpr (MODE == 2) {
        const f32x2* rp = a.rope + (size_t)(a.qpos0 + wid * 32 + r32) * 32 + hi * 8;
#pragma unroll
        for (int dd = 0; dd < 2; ++dd) {
            bf16x8 x1 = *(const bf16x8*)(Qw + (8 + dd) * 16), x2 = *(const bf16x8*)(Qw + (10 + dd) * 16); bf16x8 y1, y2;
#pragma unroll
            for (int j = 0; j < 8; ++j) { const f32x2 cs = rp[dd * 16 + j]; const float a1 = bf2f((unsigned short)x1[j]), a2 = bf2f((unsigned short)x2[j]);
                y1[j] = (short)f2bf(a1 * cs.x - a2 * cs.y); y2[j] = (short)f2bf(a1 * cs.y + a2 * cs.x); }
            *(bf16x8*)(qrl + (8 + dd - NQR) * 1024) = y1; *(bf16x8*)(qrl + (10 + dd - NQR) * 1024) = y2; }
#pragma unroll
        for (int d0 = NQR; d0 < 8; ++d0) *(bf16x8*)(qrl + (d0 - NQR) * 1024) = *(const bf16x8*)(Qw + d0 * 16);
    }
    const int sr = tid >> 4, sc = (tid & 15) * 8, vst0 = v_st(sr, sc), vst1 = v_st(32 + sr, sc);
    const bf16_t* vp0 = a.V + (size_t)sr * a.ldv + sc; const bf16_t* vp1 = a.V + (size_t)(32 + sr) * a.ldv + sc;
    const bf16_t* kp[KCH]; int kld[KCH], kdst[KCH];
#pragma unroll
    for (int i = 0; i < KCH; ++i) { const int e = tid + i * NTHR, row = e / CPR, c = e % CPR;
        if (MODE == 2 && c >= 16) { kp[i] = a.K2 + (size_t)row * a.ldk2 + (c - 16) * 8; kld[i] = a.ldk2; }
        else { kp[i] = a.K + (size_t)row * a.ldk + c * 8; kld[i] = a.ldk; }
        kdst[i] = row * KROWB + ((c * 16) ^ ksw(row)); }
    const int vb0 = (int)(uintptr_t)V_lds + v_rd_base(lane);
    struct { bf16x8 vs0, vs1, ks[KCH]; } st_[SD];
#define SLOAD(i, k0) do { st_[i].vs0 = *(const bf16x8*)(vp0 + (size_t)(k0) * a.ldv); st_[i].vs1 = *(const bf16x8*)(vp1 + (size_t)(k0) * a.ldv); \
    _Pragma("unroll") for (int _q = 0; _q < KCH; ++_q) st_[i].ks[_q] = *(const bf16x8*)(kp[_q] + (size_t)(k0) * kld[_q]); } while (0)
#define SWRITE(b, i) do { *(bf16x8*)(V_lds + (b) * SHM_V + vst0) = st_[i].vs0; *(bf16x8*)(V_lds + (b) * SHM_V + vst1) = st_[i].vs1; \
    _Pragma("unroll") for (int _q = 0; _q < KCH; ++_q) *(bf16x8*)(K_lds + (b) * SHM_K + kdst[_q]) = st_[i].ks[_q]; } while (0)
#define SWAIT() do { if constexpr (SD == 2) { if constexpr (KCH == 1) asm volatile("s_waitcnt vmcnt(3)" ::: "memory"); else asm volatile("s_waitcnt vmcnt(4)" ::: "memory"); } \
    else asm volatile("s_waitcnt vmcnt(0)" ::: "memory"); } while (0)
#define RESC(al) do { if (__any((al) < 1.f)) { if (hi == 0) al_l[r32] = (al); asm volatile("s_waitcnt lgkmcnt(0)" ::: "memory"); \
    _Pragma("unroll") for (int d = 0; d < 4; ++d) _Pragma("unroll") for (int r = 0; r < 16; ++r) o[d][r] *= al_l[crow(r, hi)]; } } while (0)
#if ATT_DMA
    constexpr int NI = 2 + KCH;
    const bf16_t* sp[NI]; int sld[NI];
#pragma unroll
    for (int i = 0; i < NI; ++i) { const int b = wid + 8 * i;
        if (i < 2) { const int pos = b * 1024 + lane * 16, stl = pos >> 9, q = (pos & 511) >> 1, kk = (stl >> 2) * 8 + (q >> 5), c = (stl & 3) * 32 + (q & 31);
            const int k = (kk & ~0xC) | ((kk & 4) << 1) | ((kk & 8) >> 1);
            sp[i] = a.V + (size_t)k * a.ldv + c; sld[i] = a.ldv;
        } else { const int pos = (b - 16) * 1024 + lane * 16, row = pos / KROWB, within = pos - row * KROWB, c = (within ^ ksw(row)) >> 4;
            if (MODE == 2 && c >= 16) { sp[i] = a.K2 + (size_t)row * a.ldk2 + (c - 16) * 8; sld[i] = a.ldk2; }
            else { sp[i] = a.K + (size_t)row * a.ldk + c * 8; sld[i] = a.ldk; } } }
    const int wu = __builtin_amdgcn_readfirstlane(wid);
#define DMA(buf, k0) do { _Pragma("unroll") for (int _i = 0; _i < NI; ++_i) { \
        char* _d = (_i < 2) ? V_lds + (buf) * SHM_V + (wu + 8 * _i) * 1024 : K_lds + (buf) * SHM_K + (wu + 8 * _i - 16) * 1024; \
        __builtin_amdgcn_global_load_lds((const unsigned*)(sp[_i] + (size_t)(k0) * sld[_i]), (LAS unsigned*)_d, 16, 0, 0); } } while (0)
#endif
    constexpr int NB = (KROWB == 256) ? 8 : 4;
    int kb[NB];
    { const int X = (hi * 16) ^ ksw(r32);
#pragma unroll
      for (int i = 0; i < NB; ++i) kb[i] = (int)(uintptr_t)K_lds + r32 * KROWB + ((i * 32) ^ X); }
    const int qra = (int)(uintptr_t)qrl;
    auto qkt = [&](f32x16& p0, f32x16& p1, const int kofs) {
        p0 = f32x16{}; p1 = f32x16{};
        int kc[NB];
#pragma unroll
        for (int i = 0; i < NB; ++i) kc[i] = kb[i] + kofs;
        bf16x8 fk[2][2]; bf16x8 fq[2];
        auto rd = [&](auto ic) { constexpr int d0 = decltype(ic)::value; constexpr int sl = d0 & 1;
            dsr128<(d0 / NB) * (NB * 32)>(fk[sl][0], kc[d0 % NB]); dsr128<(d0 / NB) * (NB * 32) + 32 * KROWB>(fk[sl][1], kc[d0 % NB]);
            if constexpr (MODE == 2 && d0 >= NQR) dsr128<(d0 - NQR) * 1024>(fq[sl], qra); };
        rd(std::integral_constant<int, 0>{});
        cfor<0, ND0>([&](auto ic) { constexpr int d0 = decltype(ic)::value; constexpr int sl = d0 & 1;
            if constexpr (d0 + 1 < ND0) { rd(std::integral_constant<int, d0 + 1>{}); wait_lgkm<(MODE == 2 && d0 + 1 >= NQR) ? 3 : 2>(); }
            else wait_lgkm<0>();
            SBAR();
            bf16x8 qf; if constexpr (MODE == 2 && d0 >= NQR) qf = fq[sl]; else qf = qr[d0 < NQR ? d0 : 0];
            p0 = __builtin_amdgcn_mfma_f32_32x32x16_bf16(fk[sl][0], qf, p0, 0, 0, 0);
            p1 = __builtin_amdgcn_mfma_f32_32x32x16_bf16(fk[sl][1], qf, p1, 0, 0, 0); });
    };
    const int qw0 = a.qpos0 + wid * 32;
    auto partialSM = [&](f32x16& p0, f32x16& p1, float& mn, float& alpha, int k0) {
        if constexpr (MODE == 1) {
            const int relmax = k0 + 63 - qw0, relmin = k0 - qw0 - 31;
            if (relmax <= -128 || relmin >= 128) {
                const float bc = a.tab[relmax <= -128 ? 0 : 256];
                float pmax = p0[0];
#pragma unroll
                for (int r = 1; r < 16; ++r) pmax = fmaxf(pmax, p0[r]);
#pragma unroll
                for (int r = 0; r < 16; ++r) pmax = fmaxf(pmax, p1[r]);
                { auto rr = __builtin_amdgcn_permlane32_swap(__float_as_uint(pmax), __float_as_uint(pmax), false, false);
                  pmax = fmaxf(__uint_as_float(rr[0]), __uint_as_float(rr[1])); }
                pmax = fmaf(pmax, C, bc);
                if (__builtin_expect(__all(pmax - m_reg <= THR_L2), 1)) { mn = m_reg; alpha = 1.f; }
                else { mn = fmaxf(m_reg, pmax); alpha = __builtin_amdgcn_exp2f(m_reg - mn); m_reg = mn; }
                const float off = bc - mn;
#pragma unroll
                for (int r = 0; r < 16; ++r) { p0[r] = fmaf(p0[r], C, off); p1[r] = fmaf(p1[r], C, off); }
            } else {
                const int base = k0 - (qw0 + r32) + 4 * hi + 128;
#pragma unroll
                for (int r = 0; r < 16; ++r) { const int i0 = base + (r & 3) + 8 * (r >> 2);
                    const int j0 = min(max(i0, 0), 256), j1 = min(max(i0 + 32, 0), 256);
                    p0[r] = fmaf(p0[r], C, a.tab[j0]); p1[r] = fmaf(p1[r], C, a.tab[j1]); }
                float pmax = p0[0];
#pragma unroll
                for (int r = 1; r < 16; ++r) pmax = fmaxf(pmax, p0[r]);
#pragma unroll
                for (int r = 0; r < 16; ++r) pmax = fmaxf(pmax, p1[r]);
                { auto rr = __builtin_amdgcn_permlane32_swap(__float_as_uint(pmax), __float_as_uint(pmax), false, false);
                  pmax = fmaxf(__uint_as_float(rr[0]), __uint_as_float(rr[1])); }
                if (__builtin_expect(__all(pmax - m_reg <= THR_L2), 1)) { mn = m_reg; alpha = 1.f; }
                else { mn = fmaxf(m_reg, pmax); alpha = __builtin_amdgcn_exp2f(m_reg - mn); m_reg = mn; }
#pragma unroll
                for (int r = 0; r < 16; ++r) { p0[r] -= mn; p1[r] -= mn; }
            }
#pragma unroll
            for (int r = 0; r < 16; ++r) p0[r] = __builtin_amdgcn_exp2f(p0[r]);
        } else {
            float pmax = p0[0];
#pragma unroll
            for (int r = 1; r < 16; ++r) pmax = fmaxf(pmax, p0[r]);
#pragma unroll
            for (int r = 0; r < 16; ++r) pmax = fmaxf(pmax, p1[r]);
            { auto rr = __builtin_amdgcn_permlane32_swap(__float_as_uint(pmax), __float_as_uint(pmax), false, false);
              pmax = fmaxf(__uint_as_float(rr[0]), __uint_as_float(rr[1])); }
            if (__builtin_expect(__all((pmax - m_reg) * C <= THR_L2), 1)) { mn = m_reg; alpha = 1.f; }
            else { mn = fmaxf(m_reg, pmax); alpha = __builtin_amdgcn_exp2f((m_reg - mn) * C); m_reg = mn; }
            const float mnC = -mn * C;
#pragma unroll
            for (int r = 0; r < 16; ++r) { p0[r] = fmaf(p0[r], C, mnC); p1[r] = fmaf(p1[r], C, mnC); }
#pragma unroll
            for (int r = 0; r < 16; ++r) p0[r] = __builtin_amdgcn_exp2f(p0[r]);
        }
    };
    auto finishSM = [&](f32x16& p0, f32x16& p1, float alpha, bf16x8& pa0, bf16x8& pa1, bf16x8& pa2, bf16x8& pa3) {
#pragma unroll
        for (int r = 0; r < 16; ++r) p1[r] = __builtin_amdgcn_exp2f(p1[r]);
        float ps = 0;
#pragma unroll
        for (int r = 0; r < 16; ++r) ps += p0[r];
#pragma unroll
        for (int r = 0; r < 16; ++r) ps += p1[r];
        { auto rr = __builtin_amdgcn_permlane32_swap(__float_as_uint(ps), __float_as_uint(ps), false, false);
          ps = __uint_as_float(rr[0]) + __uint_as_float(rr[1]); }
        l_reg = l_reg * alpha + ps;
#define PK4(P, BASE, OUT) do { unsigned a0 = cvtpk(P[BASE + 0], P[BASE + 1]), a1 = cvtpk(P[BASE + 2], P[BASE + 3]);   \
    unsigned b0 = cvtpk(P[BASE + 4], P[BASE + 5]), b1 = cvtpk(P[BASE + 6], P[BASE + 7]);                              \
    auto r0 = __builtin_amdgcn_permlane32_swap(a0, b0, false, false); auto r1 = __builtin_amdgcn_permlane32_swap(a1, b1, false, false); \
    u32x4 w = {r0[0], r1[0], r0[1], r1[1]}; OUT = *reinterpret_cast<bf16x8*>(&w); } while (0)
        PK4(p0, 0, pa0); PK4(p0, 8, pa1); PK4(p1, 0, pa2); PK4(p1, 8, pa3);
#undef PK4
    };
    bf16x8 pa0, pa1, pa2, pa3; const int NT = a.seq / 64;
    if constexpr ((PIPE2_MODES >> MODE) & 1) {
        auto qkt_c = [&](f32x16& p0, f32x16& p1, const char* Ks) {
            p0 = f32x16{}; p1 = f32x16{};
#pragma unroll
            for (int d0 = 0; d0 < ND0; ++d0) { const int cb = (d0 * 16 + hi * 8) * 2;
                const bf16x8 b0 = *(const bf16x8*)(Ks + r32 * KROWB + (cb ^ ksw(r32)));
                const bf16x8 b1 = *(const bf16x8*)(Ks + (32 + r32) * KROWB + (cb ^ ksw(r32)));
                bf16x8 qf; if constexpr (MODE == 2) { if (d0 >= NQR) qf = *(const bf16x8*)(qrl + (d0 - NQR) * 1024); else qf = qr[d0 < NQR ? d0 : 0]; } else qf = qr[d0];
                p0 = __builtin_amdgcn_mfma_f32_32x32x16_bf16(b0, qf, p0, 0, 0, 0);
                p1 = __builtin_amdgcn_mfma_f32_32x32x16_bf16(b1, qf, p1, 0, 0, 0); }
        };
        f32x16 pA0, pA1, pB0, pB1; float mnA, mnB, alA, alB;
        SLOAD(0, 0); asm volatile("s_waitcnt vmcnt(0)" ::: "memory"); SWRITE(0, 0); __syncthreads();
        qkt_c(pA0, pA1, K_lds); partialSM(pA0, pA1, mnA, alA, 0);
        SLOAD(0, 64);
        SWRITE(1, 0); __syncthreads();
#pragma unroll 1
        for (int j = 1; j + 1 < NT; j += 2) {
            SBAR(); qkt_c(pB0, pB1, K_lds + SHM_K);
            finishSM(pA0, pA1, alA, pa0, pa1, pa2, pa3); SBAR();
            SLOAD(0, (j + 1) * 64); SBAR();
            pv_d0_s(o, vb0, pa0, pa1, pa2, pa3); partialSM(pB0, pB1, mnB, alB, j * 64);
            __syncthreads(); SWRITE(0, 0);
            RESC(alB); __syncthreads();
            SBAR(); qkt_c(pA0, pA1, K_lds);
            finishSM(pB0, pB1, alB, pa0, pa1, pa2, pa3); SBAR();
            SLOAD(0, (j + 2) * 64); SBAR();
            pv_d0_s(o, vb0 + SHM_V, pa0, pa1, pa2, pa3); partialSM(pA0, pA1, mnA, alA, (j + 1) * 64);
            __syncthreads(); SWRITE(1, 0);
            RESC(alA); __syncthreads();
        }
        SBAR(); qkt_c(pB0, pB1, K_lds + SHM_K);
        finishSM(pA0, pA1, alA, pa0, pa1, pa2, pa3); SBAR();
        pv_d0_s(o, vb0, pa0, pa1, pa2, pa3); partialSM(pB0, pB1, mnB, alB, (NT - 1) * 64);
        __syncthreads(); RESC(alB);
        finishSM(pB0, pB1, alB, pa0, pa1, pa2, pa3); SBAR();
        pv_d0_s(o, vb0 + SHM_V, pa0, pa1, pa2, pa3);
        __syncthreads();
    } else {
#if ATT_DMA
    DMA(0, 0); asm volatile("s_waitcnt vmcnt(0)" ::: "memory"); __syncthreads();
    if (wid >= 4) __builtin_amdgcn_s_setprio(1);
#pragma unroll 1
    for (int j = 0; j < NT; ++j) {
        const int cur = j & 1;
        if (j + 1 < NT) DMA(cur ^ 1, (j + 1) * 64);
        f32x16 p0, p1; float mn, alpha;
        qkt(p0, p1, cur * SHM_K);
        partialSM(p0, p1, mn, alpha, j * 64);
        finishSM(p0, p1, alpha, pa0, pa1, pa2, pa3);
        RESC(alpha);
        pv_d0(o, vb0 + cur * SHM_V, pa0, pa1, pa2, pa3);
        asm volatile("s_waitcnt vmcnt(0)" ::: "memory");
        __syncthreads();
    }
    __builtin_amdgcn_s_setprio(0);
#else
    SLOAD(0, 0); asm volatile("s_waitcnt vmcnt(0)" ::: "memory"); SWRITE(0, 0); __syncthreads();
    if (wid >= 4) __builtin_amdgcn_s_setprio(1);
#pragma unroll 1
    for (int j = 0; j < NT; ++j) {
        const int cur = j & 1;
        if (j + 1 < NT) SLOAD(0, (j + 1) * 64);
        f32x16 p0, p1; float mn, alpha;
        qkt(p0, p1, cur * SHM_K);
        partialSM(p0, p1, mn, alpha, j * 64);
        finishSM(p0, p1, alpha, pa0, pa1, pa2, pa3);
        RESC(alpha);
        pv_d0(o, vb0 + cur * SHM_V, pa0, pa1, pa2, pa3);
        if (j + 1 < NT) SWRITE(cur ^ 1, 0);
        __syncthreads();
    }
    __builtin_amdgcn_s_setprio(0);
#endif
    }
    if (hi == 0) li_l[r32] = l_reg; asm volatile("s_waitcnt lgkmcnt(0)" ::: "memory");
    char* ost = lds + wid * 8192;
#pragma unroll
    for (int r = 0; r < 16; ++r) { const int orow = crow(r, hi); const float rl = __builtin_amdgcn_rcpf(li_l[orow]);
#pragma unroll
        for (int d0 = 0; d0 < 4; ++d0) *(bf16_t*)(ost + orow * 256 + (d0 * 32 + r32) * 2) = f2bf(o[d0][r] * rl); }
    asm volatile("s_waitcnt lgkmcnt(0)" ::: "memory");
    {
        const int row = lane >> 1, hf = lane & 1;
        bf16_t* gp = a.O + (size_t)(wid * 32 + row) * a.ldo + hf * 64;
        const char* sp = ost + row * 256 + hf * 128;
        if (MODE != 1 || a.map == 0) {
#pragma unroll
            for (int c = 0; c < 8; ++c) *(u32x4*)(gp + c * 8) = *(const u32x4*)(sp + c * 16);
        } else {
            float v[64]; float ss = 0.f;
#pragma unroll
            for (int c = 0; c < 8; ++c) { const u32x4 w2 = *(const u32x4*)(sp + c * 16); const u32x4 w1 = *(const u32x4*)(gp + c * 8);
                v[c * 8 + 0] = bflo(w1.x) - a.lam * bflo(w2.x); v[c * 8 + 1] = bfhi(w1.x) - a.lam * bfhi(w2.x);
                v[c * 8 + 2] = bflo(w1.y) - a.lam * bflo(w2.y); v[c * 8 + 3] = bfhi(w1.y) - a.lam * bfhi(w2.y);
                v[c * 8 + 4] = bflo(w1.z) - a.lam * bflo(w2.z); v[c * 8 + 5] = bfhi(w1.z) - a.lam * bfhi(w2.z);
                v[c * 8 + 6] = bflo(w1.w) - a.lam * bflo(w2.w); v[c * 8 + 7] = bfhi(w1.w) - a.lam * bfhi(w2.w); }
#pragma unroll
            for (int i = 0; i < 64; ++i) ss += v[i] * v[i];
            ss += sx<1>(ss);
            const float rn = rsqrtf(ss * (1.f / 128.f) + EPS) * a.oscale;
            const float* gg = a.ga + hf * 64;
#pragma unroll
            for (int c = 0; c < 8; ++c) { const f32x4 g0 = *(const f32x4*)(gg + c * 8), g1 = *(const f32x4*)(gg + c * 8 + 4);
                u32x4 w; w.x = cvtpk(v[c * 8] * rn * g0[0], v[c * 8 + 1] * rn * g0[1]); w.y = cvtpk(v[c * 8 + 2] * rn * g0[2], v[c * 8 + 3] * rn * g0[3]);
                w.z = cvtpk(v[c * 8 + 4] * rn * g1[0], v[c * 8 + 5] * rn * g1[1]); w.w = cvtpk(v[c * 8 + 6] * rn * g1[2], v[c * 8 + 7] * rn * g1[3]);
                *(u32x4*)(gp + c * 8) = w; }
        }
    }
#undef SLOAD
#undef SWRITE
#undef SWAIT
#undef RESC
}
constexpr int ATT_AUX = 2 * 16384 + 2 * 64 * 384 + 8 * 64 * 4;
constexpr int ATT_TAB = ATT_AUX;
constexpr int ATT_IDX = ATT_AUX + 1040;

#ifndef A_DUAL
#define A_DUAL 0
#endif
#ifndef A_DUAL_VRING
#define A_DUAL_VRING 1
#endif
DI void attn_body_dual(const AttnArgs& a, char* lds) {
    constexpr int KROWB = 256, SHM_K = 64 * KROWB, SHM_V = 64 * 128 * 2, NI = 4, NB = 8;
    int tid = a.tid; asm volatile("" : "+v"(tid));
    const int wid = tid >> 6, lane = tid & 63, r32 = lane & 31, hi = lane >> 5;
    char* V_lds = lds; char* K_lds = lds + 2 * SHM_V;
    float* wsc = (float*)(lds + ATT_WSC) + wid * 64; float* li_l = wsc; float* al_l = wsc + 32;
    float m_reg, l_reg, mS0 = -1e30f, mS1 = -1e30f, lS0 = 0.f, lS1 = 0.f; f32x16 o1[4] = {}, o2[4] = {};
    char* qrl = lds + ATT_QR + wid * 8192 + lane * 16;
    const float C = a.C;
    auto ksw = [](int row) { return ((row & 7) | (((row >> 4) & 1) << 3)) << 4; };
    __syncthreads();
    const bf16_t* Qw = a.Q + (size_t)(wid * 32 + r32) * a.ldq + hi * 8;
#pragma unroll
    for (int d0 = 0; d0 < 8; ++d0) *(bf16x8*)(qrl + d0 * 1024) = *(const bf16x8*)(Qw + d0 * 16);
    const int qra = (int)(uintptr_t)qrl;
    const int vb0 = (int)(uintptr_t)V_lds + v_rd_base(lane);
    const bf16_t* sp[NI]; int sld[NI];
#pragma unroll
    for (int i = 0; i < NI; ++i) { const int b = wid + 8 * i;
        if (i < 2) { const int pos = b * 1024 + lane * 16, stl = pos >> 9, q = (pos & 511) >> 1, kk = (stl >> 2) * 8 + (q >> 5), c = (stl & 3) * 32 + (q & 31);
            const int k = (kk & ~0xC) | ((kk & 4) << 1) | ((kk & 8) >> 1);
            sp[i] = a.V + (size_t)k * a.ldv + c; sld[i] = a.ldv;
        } else { const int pos = (b - 16) * 1024 + lane * 16, row = pos / KROWB, within = pos - row * KROWB, c = (within ^ ksw(row)) >> 4;
            sp[i] = a.K + (size_t)row * a.ldk + c * 8; sld[i] = a.ldk; } }
    const int wu = __builtin_amdgcn_readfirstlane(wid);
#define DMA2(buf, k0) do { _Pragma("unroll") for (int _i = 0; _i < NI; ++_i) { \
        char* _d = (_i < 2) ? V_lds + (buf) * SHM_V + (wu + 8 * _i) * 1024 : K_lds + (buf) * SHM_K + (wu + 8 * _i - 16) * 1024; \
        __builtin_amdgcn_global_load_lds((const unsigned*)(sp[_i] + (size_t)(k0) * sld[_i]), (LAS unsigned*)_d, 16, 0, 0); } } while (0)
#define RESC2(O, al) do { if (__any((al) < 1.f)) { if (hi == 0) al_l[r32] = (al); asm volatile("s_waitcnt lgkmcnt(0)" ::: "memory"); \
    _Pragma("unroll") for (int d = 0; d < 4; ++d) _Pragma("unroll") for (int r = 0; r < 16; ++r) O[d][r] *= al_l[crow(r, hi)]; } } while (0)
    const int kX = (hi * 16) ^ ksw(r32), kbase = (int)(uintptr_t)K_lds + r32 * KROWB;
    auto qkt = [&](auto mc, f32x16& p0, f32x16& p1, const int kofs) {
        constexpr int M = decltype(mc)::value;
        p0 = f32x16{}; p1 = f32x16{};
        bf16x8 fk[2][2], fq[2];
        auto rd = [&](auto ic) { constexpr int d0 = decltype(ic)::value; constexpr int sl = d0 & 1;
            const int ka = kbase + kofs + (((4 * M + d0) * 32) ^ kX); dsr128<0>(fk[sl][0], ka); dsr128<32 * KROWB>(fk[sl][1], ka); dsr128<(4 * M + d0) * 1024>(fq[sl], qra); };
        rd(std::integral_constant<int, 0>{});
        cfor<0, 4>([&](auto ic) { constexpr int d0 = decltype(ic)::value; constexpr int sl = d0 & 1;
            if constexpr (d0 + 1 < 4) { rd(std::integral_constant<int, d0 + 1>{}); wait_lgkm<3>(); } else wait_lgkm<0>();
            SBAR();
            p0 = __builtin_amdgcn_mfma_f32_32x32x16_bf16(fk[sl][0], fq[sl], p0, 0, 0, 0);
            p1 = __builtin_amdgcn_mfma_f32_32x32x16_bf16(fk[sl][1], fq[sl], p1, 0, 0, 0); });
    };
    const int qw0 = a.qpos0 + wid * 32;
    auto softmax = [&](f32x16& p0, f32x16& p1, float& alpha, bf16x8* pa, const int k0) {
        float mn;
        const int relmax = k0 + 63 - qw0, relmin = k0 - qw0 - 31;
        if (relmax <= -128 || relmin >= 128) {
            const float bc = a.tab[relmax <= -128 ? 0 : 256];
            float pmax = p0[0];
#pragma unroll
            for (int r = 1; r < 16; ++r) pmax = fmaxf(pmax, p0[r]);
#pragma unroll
            for (int r = 0; r < 16; ++r) pmax = fmaxf(pmax, p1[r]);
            { auto rr = __builtin_amdgcn_permlane32_swap(__float_as_uint(pmax), __float_as_uint(pmax), false, false);
              pmax = fmaxf(__uint_as_float(rr[0]), __uint_as_float(rr[1])); }
            pmax = fmaf(pmax, C, bc);
            if (__builtin_expect(__all(pmax - m_reg <= THR_L2), 1)) { mn = m_reg; alpha = 1.f; }
            else { mn = fmaxf(m_reg, pmax); alpha = __builtin_amdgcn_exp2f(m_reg - mn); m_reg = mn; }
            const float off = bc - mn;
#pragma unroll
            for (int r = 0; r < 16; ++r) { p0[r] = fmaf(p0[r], C, off); p1[r] = fmaf(p1[r], C, off); }
        } else {
            const int base = k0 - (qw0 + r32) + 4 * hi + 128;
#pragma unroll
            for (int r = 0; r < 16; ++r) { const int i0 = base + (r & 3) + 8 * (r >> 2); p0[r] = fmaf(p0[r], C, a.tab[min(max(i0, 0), 256)]); }
            SBAR();
#pragma unroll
            for (int r = 0; r < 16; ++r) { const int i0 = base + 32 + (r & 3) + 8 * (r >> 2); p1[r] = fmaf(p1[r], C, a.tab[min(max(i0, 0), 256)]); }
            SBAR();
            float pmax = p0[0];
#pragma unroll
            for (int r = 1; r < 16; ++r) pmax = fmaxf(pmax, p0[r]);
#pragma unroll
            for (int r = 0; r < 16; ++r) pmax = fmaxf(pmax, p1[r]);
            { auto rr = __builtin_amdgcn_permlane32_swap(__float_as_uint(pmax), __float_as_uint(pmax), false, false);
              pmax = fmaxf(__uint_as_float(rr[0]), __uint_as_float(rr[1])); }
            if (__builtin_expect(__all(pmax - m_reg <= THR_L2), 1)) { mn = m_reg; alpha = 1.f; }
            else { mn = fmaxf(m_reg, pmax); alpha = __builtin_amdgcn_exp2f(m_reg - mn); m_reg = mn; }
#pragma unroll
            for (int r = 0; r < 16; ++r) { p0[r] -= mn; p1[r] -= mn; }
        }
#pragma unroll
        for (int r = 0; r < 16; ++r) { p0[r] = __builtin_amdgcn_exp2f(p0[r]); p1[r] = __builtin_amdgcn_exp2f(p1[r]); }
        float ps = 0;
#pragma unroll
        for (int r = 0; r < 16; ++r) ps += p0[r];
#pragma unroll
        for (int r = 0; r < 16; ++r) ps += p1[r];
        { auto rr = __builtin_amdgcn_permlane32_swap(__float_as_uint(ps), __float_as_uint(ps), false, false);
          ps = __uint_as_float(rr[0]) + __uint_as_float(rr[1]); }
        l_reg = l_reg * alpha + ps;
#define PK4(P, BASE, OUT) do { unsigned a0 = cvtpk(P[BASE + 0], P[BASE + 1]), a1 = cvtpk(P[BASE + 2], P[BASE + 3]);   \
    unsigned b0 = cvtpk(P[BASE + 4], P[BASE + 5]), b1 = cvtpk(P[BASE + 6], P[BASE + 7]);                              \
    auto r0 = __builtin_amdgcn_permlane32_swap(a0, b0, false, false); auto r1 = __builtin_amdgcn_permlane32_swap(a1, b1, false, false); \
    u32x4 w = {r0[0], r1[0], r0[1], r1[1]}; OUT = *reinterpret_cast<bf16x8*>(&w); } while (0)
        PK4(p0, 0, pa[0]); PK4(p0, 8, pa[1]); PK4(p1, 0, pa[2]); PK4(p1, 8, pa[3]);
#undef PK4
    };
    const int NT = a.seq / 64;
    DMA2(0, 0); asm volatile("s_waitcnt vmcnt(0)" ::: "memory"); __syncthreads();
    if (wid >= 4) __builtin_amdgcn_s_setprio(1);
#pragma unroll 1
    for (int j = 0; j < NT; ++j) {
        const int cur = j & 1;
        if (j + 1 < NT) DMA2(cur ^ 1, (j + 1) * 64);
        f32x16 p0, p1; float alpha; bf16x8 paA[4], paB[4];
        qkt(std::integral_constant<int, 0>{}, p0, p1, cur * SHM_K);
        m_reg = mS0; l_reg = lS0; softmax(p0, p1, alpha, paA, j * 64); mS0 = m_reg; lS0 = l_reg;
        RESC2(o1, alpha);
        qkt(std::integral_constant<int, 1>{}, p0, p1, cur * SHM_K);
        m_reg = mS1; l_reg = lS1; softmax(p0, p1, alpha, paB, j * 64); mS1 = m_reg; lS1 = l_reg;
        RESC2(o2, alpha);
        const int vb = vb0 + cur * SHM_V;
#if A_DUAL_VRING
        s16x4 fa[8], fb[8];
        v_rd8<0>(fa, vb);
        v_rd8<1>(fb, vb); wait_lgkm<8>(); SBAR(); pv_mm(o1, fa, paA[0]); pv_mm(o2, fa, paB[0]);
        v_rd8<2>(fa, vb); wait_lgkm<8>(); SBAR(); pv_mm(o1, fb, paA[1]); pv_mm(o2, fb, paB[1]);
        v_rd8<3>(fb, vb); wait_lgkm<8>(); SBAR(); pv_mm(o1, fa, paA[2]); pv_mm(o2, fa, paB[2]);
        wait_lgkm<0>(); SBAR(); pv_mm(o1, fb, paA[3]); pv_mm(o2, fb, paB[3]);
#else
        s16x4 fa[8];
        v_rd8<0>(fa, vb); wait_lgkm<0>(); SBAR(); pv_mm(o1, fa, paA[0]); pv_mm(o2, fa, paB[0]); SBAR();
        v_rd8<1>(fa, vb); wait_lgkm<0>(); SBAR(); pv_mm(o1, fa, paA[1]); pv_mm(o2, fa, paB[1]); SBAR();
        v_rd8<2>(fa, vb); wait_lgkm<0>(); SBAR(); pv_mm(o1, fa, paA[2]); pv_mm(o2, fa, paB[2]); SBAR();
        v_rd8<3>(fa, vb); wait_lgkm<0>(); SBAR(); pv_mm(o1, fa, paA[3]); pv_mm(o2, fa, paB[3]);
#endif
        asm volatile("s_waitcnt vmcnt(0)" ::: "memory");
        __syncthreads();
    }
    __builtin_amdgcn_s_setprio(0);
    if (hi == 0) { li_l[r32] = lS0; al_l[r32] = lS1; } asm volatile("s_waitcnt lgkmcnt(0)" ::: "memory");
    char* ost = lds + wid * 8192;
#pragma unroll
    for (int r = 0; r < 16; ++r) { const int orow = crow(r, hi); const float rl1 = __builtin_amdgcn_rcpf(li_l[orow]), rl2 = __builtin_amdgcn_rcpf(al_l[orow]) * a.lam;
#pragma unroll
        for (int d0 = 0; d0 < 4; ++d0) *(bf16_t*)(ost + orow * 256 + (d0 * 32 + r32) * 2) = f2bf(o1[d0][r] * rl1 - o2[d0][r] * rl2); }
    asm volatile("s_waitcnt lgkmcnt(0)" ::: "memory");
    { const int row = lane >> 1, hf = lane & 1;
      bf16_t* gp = a.O + (size_t)(wid * 32 + row) * a.ldo + hf * 64; const char* spp = ost + row * 256 + hf * 128;
      float v[64]; float ss = 0.f;
#pragma unroll
      for (int c = 0; c < 8; ++c) { const u32x4 w = *(const u32x4*)(spp + c * 16);
          v[c * 8 + 0] = bflo(w.x); v[c * 8 + 1] = bfhi(w.x); v[c * 8 + 2] = bflo(w.y); v[c * 8 + 3] = bfhi(w.y);
          v[c * 8 + 4] = bflo(w.z); v[c * 8 + 5] = bfhi(w.z); v[c * 8 + 6] = bflo(w.w); v[c * 8 + 7] = bfhi(w.w); }
#pragma unroll
      for (int i = 0; i < 64; ++i) ss += v[i] * v[i];
      ss += sx<1>(ss);
      const float rn = rsqrtf(ss * (1.f / 128.f) + EPS) * a.oscale; const float* gg = a.ga + hf * 64;
#pragma unroll
      for (int c = 0; c < 8; ++c) { const f32x4 g0 = *(const f32x4*)(gg + c * 8), g1 = *(const f32x4*)(gg + c * 8 + 4);
          u32x4 w; w.x = cvtpk(v[c * 8] * rn * g0[0], v[c * 8 + 1] * rn * g0[1]); w.y = cvtpk(v[c * 8 + 2] * rn * g0[2], v[c * 8 + 3] * rn * g0[3]);
          w.z = cvtpk(v[c * 8 + 4] * rn * g1[0], v[c * 8 + 5] * rn * g1[1]); w.w = cvtpk(v[c * 8 + 6] * rn * g1[2], v[c * 8 + 7] * rn * g1[3]);
          *(u32x4*)(gp + c * 8) = w; } }
#undef DMA2
#undef RESC2
}

DI void cvt_job(const float* __restrict__ src, int K, int N, int Npad, bf16_t* __restrict__ dst, int mode, float* tile, const int tid) {
    const int nkt = K / 64, ntile = nkt * (Npad / 256);
    const int r = tid >> 6, c = (tid & 63) * 4, u0 = c >> 6, cc = c & 63, wn = tid >> 3, kc = (tid & 7) * 8;
    for (int t = blockIdx.x; t < ntile; t += gridDim.x) {
        const int nt_ = t / nkt, kt = t - nt_ * nkt, k0 = kt * 64, n0 = nt_ * 256;
        f32x4 v[8];
#pragma unroll
        for (int i = 0; i < 8; ++i) { v[i] = (f32x4){0.f, 0.f, 0.f, 0.f};
            if (n0 + c < N) v[i] = *(const f32x4*)(src + (size_t)(k0 + r + 8 * i) * N + n0 + c); }
        __syncthreads();
#pragma unroll
        for (int i = 0; i < 8; ++i) { float* tp = tile + u0 * 4160 + (r + 8 * i) * 65 + cc; tp[0] = v[i][0]; tp[1] = v[i][1]; tp[2] = v[i][2]; tp[3] = v[i][3]; }
        __syncthreads();
#pragma unroll
        for (int u = 0; u < 4; ++u) {
            float x[8];
#pragma unroll
            for (int j = 0; j < 8; ++j) x[j] = tile[u * 4160 + (kc + j) * 65 + wn];
            const int n = n0 + u * 64 + wn; const int drow = mode == 0 ? n : ((n >> 7) * 256 + (mode == 2 ? 128 : 0) + (n & 127));
            u32x4 w; w.x = cvtpk(x[0], x[1]); w.y = cvtpk(x[2], x[3]); w.z = cvtpk(x[4], x[5]); w.w = cvtpk(x[6], x[7]);
            *(u32x4*)(dst + (size_t)drow * K + k0 + kc) = w;
        }
    }
}
DI void convert_jobs(const Params& P, int l, int jlo, int jhi, unsigned char* shm) {
    const int tid_ = fresh_tid(P);
    float* tile = (float*)shm; unsigned char* ws = P.ws();
#pragma nounroll
    for (int j = jlo; j < jhi; ++j) {
        int ii, K, N, Npad, mode = 0; size_t off;
        switch (j) {
        case 0: ii = 7; K = 2048; N = NIN; Npad = LDZ; off = W1_IN; break;
        case 1: ii = 17; K = 512; N = 1536; Npad = 1536; off = W1_CQ; break;
        case 2: ii = 18; K = 256; N = 2048; Npad = 2048; off = W1_CKV; break;
        case 3: ii = 19; K = 1024; N = 2048; Npad = 2048; off = W1_BR; break;
        case 4: ii = 20; K = 1024; N = 2048; Npad = 2048; off = W1_BR + (size_t)2048 * 1024 * 2; break;
        case 5: ii = 21; K = 1024; N = 2048; Npad = 2048; off = W1_BR + (size_t)2 * 2048 * 1024 * 2; break;
        case 6: ii = 22; K = 2048; N = 2048; Npad = 2048; off = W1_MIX; break;
        case 7: ii = 26; K = 2048; N = 512; Npad = 512; off = W1_XQ; break;
        case 8: ii = 27; K = 2048; N = 1024; Npad = 1024; off = W1_XKV; break;
        case 9: ii = 28; K = 512; N = 2048; Npad = 2048; off = W1_XOUT; break;
        case 10: ii = 31; K = 2048; N = DFF; Npad = DFF; off = W2_GU; mode = 1; break;
        case 11: ii = 32; K = 2048; N = DFF; Npad = DFF; off = W2_GU; mode = 2; break;
        default: ii = 33; K = DFF; N = 2048; Npad = 2048; off = W2_DN; break;
        }
        cvt_job(P.in(ii) + (size_t)l * K * N, K, N, Npad, (bf16_t*)(ws + off), mode, tile, tid_);
    }
}
DI void norm_rows(const Params& P, int nrows, int srcsel  , const float* g, bf16_t* dst) {
    const int tid_ = fresh_tid(P);
    const int wid = tid_ >> 6, lane = tid_ & 63;
    for (int t = blockIdx.x * 8 + wid; t < nrows; t += gridDim.x * 8) {
        const float* src = srcsel == 0 ? xin_row(P, t) : (t < 512 ? P.in(2) + (size_t)t * DM : P.in(3) + (size_t)(t - 512) * DM);
        f32x4 v[8]; float ss = 0.f;
#pragma unroll
        for (int j = 0; j < 8; ++j) { v[j] = *(const f32x4*)(src + j * 256 + lane * 4); ss += v[j][0] * v[j][0] + v[j][1] * v[j][1] + v[j][2] * v[j][2] + v[j][3] * v[j][3]; }
        ss = wave_sum(ss); const float rn = rsqrtf(ss * (1.f / 2048.f) + EPS);
#pragma unroll
        for (int j = 0; j < 8; ++j) { const f32x4 gg = *(const f32x4*)(g + j * 256 + lane * 4);
            u32x2 w; w.x = cvtpk(v[j][0] * rn * gg[0], v[j][1] * rn * gg[1]); w.y = cvtpk(v[j][2] * rn * gg[2], v[j][3] * rn * gg[3]);
            *(u32x2*)(dst + (size_t)t * DM + j * 256 + lane * 4) = w; }
    }
}
DI void norm_res(const Params& P, bool first, const bf16_t* tmp, const float* gpost, const float* gpre, bf16_t* h) {
    const int tid_ = fresh_tid(P);
    const int wid = tid_ >> 6, lane = tid_ & 63;
    for (int t = blockIdx.x * 8 + wid; t < T; t += gridDim.x * 8) {
        const float* xs = first ? xin_row(P, t) : P.out() + (size_t)t * DM; float* xd = P.out() + (size_t)t * DM;
        f32x4 y[8]; float ss = 0.f;
#pragma unroll
        for (int j = 0; j < 8; ++j) { const u32x2 w = *(const u32x2*)(tmp + (size_t)t * DM + j * 256 + lane * 4);
            y[j] = (f32x4){bflo(w.x), bfhi(w.x), bflo(w.y), bfhi(w.y)}; ss += y[j][0] * y[j][0] + y[j][1] * y[j][1] + y[j][2] * y[j][2] + y[j][3] * y[j][3]; }
        ss = wave_sum(ss); const float rn = rsqrtf(ss * (1.f / 2048.f) + EPS);
        float s2 = 0.f;
#pragma unroll
        for (int j = 0; j < 8; ++j) { const f32x4 gg = *(const f32x4*)(gpost + j * 256 + lane * 4); const f32x4 xv = *(const f32x4*)(xs + j * 256 + lane * 4);
#pragma unroll
            for (int q = 0; q < 4; ++q) { y[j][q] = xv[q] + y[j][q] * rn * gg[q]; s2 += y[j][q] * y[j][q]; }
            *(f32x4*)(xd + j * 256 + lane * 4) = y[j]; }
        if (gpre) { s2 = wave_sum(s2); const float r2 = rsqrtf(s2 * (1.f / 2048.f) + EPS);
#pragma unroll
            for (int j = 0; j < 8; ++j) { const f32x4 gg = *(const f32x4*)(gpre + j * 256 + lane * 4);
                u32x2 w; w.x = cvtpk(y[j][0] * r2 * gg[0], y[j][1] * r2 * gg[1]); w.y = cvtpk(y[j][2] * r2 * gg[2], y[j][3] * r2 * gg[3]);
                *(u32x2*)(h + (size_t)t * DM + j * 256 + lane * 4) = w; } }
    }
}
DI void prep_phase(const Params& P, int l) {
    const int tid_ = fresh_tid(P);
    const int wid = tid_ >> 6, lane = tid_ & 63, half = lane >> 5, j = lane & 31;
    bf16_t* z = (bf16_t*)(P.ws() + WS_Z); const f32x2* rope = (const f32x2*)(P.ws() + WS_ROPE);
    const float* gbq = P.in(13) + l * 128; const float* gbk = P.in(14) + l * 128; const float* gcq = P.in(15) + l * 512; const float* gckv = P.in(16) + l * 256;
    float gq[4], gk[4], gcqv[8], gckvv[4];
#pragma unroll
    for (int i = 0; i < 4; ++i) { gq[i] = gbq[4 * j + i]; gk[i] = gbk[4 * j + i]; gckvv[i] = gckv[lane * 4 + i]; }
#pragma unroll
    for (int q = 0; q < 8; ++q) gcqv[q] = gcq[lane * 8 + q];
    const bool isx2 = (j >> 3) & 1; const bool iscol = (j >> 4) & 1; const int fo = 4 * (j & 7);
    constexpr int NTK = 2;
    const int stride = gridDim.x * 8;
    for (int t0 = blockIdx.x * 8 + wid; t0 < T; t0 += NTK * stride) {
        u32x2 hv[NTK][5], wkv[NTK], wkr[NTK]; u32x4 wq[NTK]; f32x4 ca[NTK], cb[NTK], ka[NTK], kb2[NTK];
#pragma unroll
        for (int r = 0; r < NTK; ++r) { const int t = t0 + r * stride; const bf16_t* zr = z + (size_t)t * LDZ;
            const int s = t < 4096 ? t : (t < 8192 ? t - 4096 : t - 8192);
            const f32x4* rp = (const f32x4*)(rope + (size_t)(iscol ? (s & 63) : (s >> 6)) * 32 + fo); ca[r] = rp[0]; cb[r] = rp[1];
            const f32x4* kp = (const f32x4*)(rope + (size_t)s * 32 + fo); ka[r] = kp[0]; kb2[r] = kp[1];
#pragma unroll
            for (int it = 0; it < 5; ++it) { const int hh = it * 2 + half; const int base = hh < 8 ? ZC_BQ + hh * 128 : ZC_BK + (hh - 8) * 128;
                hv[r][it] = *(const u32x2*)(zr + base + 4 * j); }
            wq[r] = *(const u32x4*)(zr + ZC_CQA + lane * 8); wkv[r] = *(const u32x2*)(zr + ZC_CKVA + lane * 4);
            wkr[r] = *(const u32x2*)(zr + ZC_CKR + 4 * (lane & 15)); }
#pragma unroll
        for (int r = 0; r < NTK; ++r) { const int t = t0 + r * stride; bf16_t* zr = z + (size_t)t * LDZ;
            const float cs_c[4] = {ca[r][0], ca[r][2], cb[r][0], cb[r][2]}, cs_s[4] = {ca[r][1], ca[r][3], cb[r][1], cb[r][3]};
#pragma unroll
            for (int it = 0; it < 5; ++it) { const int hh = it * 2 + half; const int base = hh < 8 ? ZC_BQ + hh * 128 : ZC_BK + (hh - 8) * 128; const bool isq = hh < 8;
                float y[4] = {bflo(hv[r][it].x), bfhi(hv[r][it].x), bflo(hv[r][it].y), bfhi(hv[r][it].y)};
                float ss = half_sum(y[0] * y[0] + y[1] * y[1] + y[2] * y[2] + y[3] * y[3]); const float rn = rsqrtf(ss * (1.f / 128.f) + EPS);
                float o[4];
#pragma unroll
                for (int i = 0; i < 4; ++i) { y[i] *= rn * (isq ? gq[i] : gk[i]); const float pt = sx<8>(y[i]);
                    o[i] = isx2 ? fmaf(pt, cs_s[i], y[i] * cs_c[i]) : fmaf(-pt, cs_s[i], y[i] * cs_c[i]); }
                u32x2 w; w.x = cvtpk(o[0], o[1]); w.y = cvtpk(o[2], o[3]); *(u32x2*)(zr + base + 4 * j) = w; }
            { const u32x4 w = wq[r]; float x[8] = {bflo(w.x), bfhi(w.x), bflo(w.y), bfhi(w.y), bflo(w.z), bfhi(w.z), bflo(w.w), bfhi(w.w)};
              float ss = 0.f;
#pragma unroll
              for (int q = 0; q < 8; ++q) ss += x[q] * x[q];
              ss = wave_sum(ss); const float rn = rsqrtf(ss * (1.f / 512.f) + EPS);
#pragma unroll
              for (int q = 0; q < 8; ++q) x[q] *= rn * gcqv[q];
              u32x4 o; o.x = cvtpk(x[0], x[1]); o.y = cvtpk(x[2], x[3]); o.z = cvtpk(x[4], x[5]); o.w = cvtpk(x[6], x[7]); *(u32x4*)(zr + ZC_CQA + lane * 8) = o; }
            { const u32x2 w = wkv[r]; float x[4] = {bflo(w.x), bfhi(w.x), bflo(w.y), bfhi(w.y)};
              float ss = wave_sum(x[0] * x[0] + x[1] * x[1] + x[2] * x[2] + x[3] * x[3]); const float rn = rsqrtf(ss * (1.f / 256.f) + EPS);
#pragma unroll
              for (int q = 0; q < 4; ++q) x[q] *= rn * gckvv[q];
              u32x2 o; o.x = cvtpk(x[0], x[1]); o.y = cvtpk(x[2], x[3]); *(u32x2*)(zr + ZC_CKVA + lane * 4) = o; }
            {
              const float kc[4] = {ka[r][0], ka[r][2], kb2[r][0], kb2[r][2]}, ks[4] = {ka[r][1], ka[r][3], kb2[r][1], kb2[r][3]};
              const float y[4] = {bflo(wkr[r].x), bfhi(wkr[r].x), bflo(wkr[r].y), bfhi(wkr[r].y)}; float o[4];
#pragma unroll
              for (int i = 0; i < 4; ++i) { const float pt = sx<8>(y[i]); o[i] = isx2 ? fmaf(pt, ks[i], y[i] * kc[i]) : fmaf(-pt, ks[i], y[i] * kc[i]); }
              if (lane < 16) { u32x2 w; w.x = cvtpk(o[0], o[1]); w.y = cvtpk(o[2], o[3]); *(u32x2*)(zr + ZC_CKR + 4 * lane) = w; } }
        }
    }
}
DI int t5_bucket(int rel) {
    const int n = rel < 0 ? -rel : rel; int b;
    if (n < 8) b = n; else if (n < 12) b = 8; else if (n < 16) b = 9; else if (n < 23) b = 10; else if (n < 32) b = 11; else if (n < 46) b = 12; else if (n < 64) b = 13; else if (n < 91) b = 14; else b = 15;
    return (rel > 0 ? 16 : 0) + b;
}
DI void init_phase(const Params& P, unsigned char* shm) {
    const int tid_ = fresh_tid(P);
    unsigned char* ws = P.ws();
    if (blockIdx.x == 0) {
        int* ctl = (int*)(ws + WS_CTL);
        if (tid_ < 16) ctl[tid_] = 0;
        { unsigned* xbw = (unsigned*)(ws + WS_XB); for (int i = tid_; i < 3456; i += NTHR) xbw[i] = 0u; }
        if (tid_ >= 64 && tid_ < 128) { const int i = tid_ - 64;
            for (int l = 0; l < NLAYER; ++l) {
                const float s1 = wave_sum(P.in(8)[l * 64 + i] * P.in(9)[l * 64 + i]), s2 = wave_sum(P.in(10)[l * 64 + i] * P.in(11)[l * 64 + i]);
                const float lam_init = l == 0 ? 0.2f : 0.35550907f;
                if (i == 0) ((float*)(ctl + 16))[l] = __expf(s1) - __expf(s2) + lam_init; } }
    }
    f32x2* rope = (f32x2*)(ws + WS_ROPE);
    for (int idx = blockIdx.x * NTHR + tid_; idx < 8192 * 32; idx += gridDim.x * NTHR) {
        const int pos = idx >> 5, i = idx & 31;
        const float inv = __builtin_amdgcn_exp2f(-(float)i * 0.41524101186092029f);
        const float ang = (float)pos * inv;
        const float kk = rintf(ang * 0.15915494309189535f);
        float rr = fmaf(-kk, 6.28125f, ang); rr = fmaf(-kk, 0.0019353071795864769f, rr);
        const float rev = rr * 0.15915494309189535f;
        rope[idx] = (f32x2){__builtin_amdgcn_cosf(rev), __builtin_amdgcn_sinf(rev)};
    }
}

template <int TYPE>
DI void attn_phase(const Params& P, int l, unsigned char* shm, const int rep, const bool cross = false) {
    const int tid_ = fresh_tid(P);
    unsigned char* ws = P.ws(); int* ctl = (int*)(ws + WS_CTL);
    bf16_t* z = (bf16_t*)(ws + WS_Z); bf16_t* ckv = (bf16_t*)(ws + WS_H); bf16_t* cq = (bf16_t*)(ws + WS_CQ); bf16_t* o = (bf16_t*)(ws + WS_O);
    int* sidx = (int*)(shm + ATT_IDX); float* tab = (float*)(shm + ATT_TAB);
    for (;;) {
        __syncthreads();
        if (tid_ == 0) *sidx = atomicAdd(ctl + (l * 4 + (cross ? 3 : TYPE)) * 2 + rep, 1);
        __syncthreads();
        const int idx = *sidx;
        if (idx >= (cross ? 256 : 512)) break;
        const bool sample = idx < 256; const int w = idx & 255, head = w >> 5, qbl = w & 31;
        const int t0 = (sample ? 32 + qbl : qbl) * 256;
        const int seqstart = sample ? 8192 : (qbl < 16 ? 0 : 4096), seqlen = sample ? 8192 : 4096;
        AttnArgs a; a.tid = tid_; a.qpos0 = t0 - seqstart; a.seq = seqlen; a.tab = tab; a.rope = nullptr; a.K2 = nullptr; a.ldk2 = 0; a.map = 0; a.lam = 0.f; a.ga = nullptr; a.oscale = 1.f;
        if constexpr (TYPE == 0) {
            const float lam_init = l == 0 ? 0.2f : 0.35550907f;
            a.lam = ((const float*)(ctl + 16))[l]; a.ga = P.in(12) + l * 128; a.oscale = 1.f - lam_init;
            const float* rb = P.in(4);
            for (int i = tid_; i < 257; i += NTHR) tab[i] = rb[t5_bucket(i - 128) * 8 + head] * LOG2E;
            a.ldq = LDZ; a.ldk = LDZ; a.ldv = LDZ; a.ldo = 3072; a.C = 0.125f * LOG2E;
            a.V = z + (size_t)seqstart * LDZ + ZC_AV + head * 128; a.O = o + (size_t)t0 * 3072 + head * 128;
#if A_DUAL
            a.Q = z + (size_t)t0 * LDZ + ZC_AQ + head * 128; a.K = z + (size_t)seqstart * LDZ + ZC_AK + head * 128;
            attn_body_dual(a, (char*)shm);
#else
#pragma nounroll
            for (int mp = 0; mp < 2; ++mp) { a.map = mp;
                a.Q = z + (size_t)t0 * LDZ + ZC_AQ + head * 128 + mp * 64; a.K = z + (size_t)seqstart * LDZ + ZC_AK + head * 128 + mp * 64;
                attn_body<64, 1>(a, (char*)shm); }
#endif
        } else if constexpr (TYPE == 1) {
            a.rope = (const f32x2*)(ws + WS_ROPE);
            a.Q = cq + (size_t)t0 * 1536 + head * 192; a.ldq = 1536; a.K = ckv + (size_t)seqstart * 2048 + head * 256; a.ldk = 2048;
            a.K2 = z + (size_t)seqstart * LDZ + ZC_CKR; a.ldk2 = LDZ; a.V = ckv + (size_t)seqstart * 2048 + head * 256 + 128; a.ldv = 2048;
            a.O = o + (size_t)t0 * 3072 + 2048 + head * 128; a.ldo = 3072; a.C = 0.07216878364870322f * LOG2E;
            attn_body<192, 2>(a, (char*)shm);
        } else if (cross) {
            const bf16_t* xq = (const bf16_t*)(ws + WS_XQ); const bf16_t* mkv = (const bf16_t*)(ws + WS_MEMKV); bf16_t* xatt = (bf16_t*)(ws + WS_XATT);
            const int xh = idx >> 6, qb = idx & 63, xt0 = qb * 256, sq = qb < 16 ? 0 : (qb < 32 ? 1 : 2);
            a.qpos0 = 0; a.seq = 256;
            a.Q = xq + (size_t)xt0 * 512 + xh * 128; a.ldq = 512; a.K = mkv + (size_t)sq * 256 * 1024 + xh * 128; a.ldk = 1024;
            a.V = mkv + (size_t)sq * 256 * 1024 + 512 + xh * 128; a.ldv = 1024; a.O = xatt + (size_t)xt0 * 512 + xh * 128; a.ldo = 512; a.C = 0.08838834764831845f * LOG2E;
            attn_body<128, 0>(a, (char*)shm);
        } else {
            const int kvh = head >> 2;
            a.Q = z + (size_t)t0 * LDZ + ZC_BQ + head * 128; a.ldq = LDZ; a.K = z + (size_t)seqstart * LDZ + ZC_BK + kvh * 128; a.ldk = LDZ;
            a.V = z + (size_t)seqstart * LDZ + ZC_BV + kvh * 128; a.ldv = LDZ; a.O = o + (size_t)t0 * 3072 + 1024 + head * 128; a.ldo = 3072; a.C = 0.08838834764831845f * LOG2E;
            attn_body<128, 0>(a, (char*)shm);
        }
    }
}
#define XB_TMO      128
#define XB_XCNT(j)  (256  + 64 * (j))
#define XB_XSUB(j)  (1280 + 64 * (j))
#define XB_XGEN(j)  (2304 + 64 * (j))
#define XB_TOP      3328
#define XB_TOPGEN   3392
#define XCD_BAR_WORDS 3456
#define XB_SPIN_CAP (1u << 20)
DI unsigned xb_ld(unsigned* p)              { return __hip_atomic_load(p, __ATOMIC_RELAXED, __HIP_MEMORY_SCOPE_AGENT); }
DI unsigned xb_add(unsigned* p, unsigned v) { return __hip_atomic_fetch_add(p, v, __ATOMIC_RELAXED, __HIP_MEMORY_SCOPE_AGENT); }
DI unsigned xb_xcc_id() { return (unsigned)__builtin_amdgcn_s_getreg((3 << 11) | 20) & 0xFu; }
#define XB_SPIN(cond, bar) do { unsigned _sp = 0; while (cond) { __builtin_amdgcn_s_sleep(1); \
    if ((++_sp & 255u) == 0u) { if (xb_ld(&(bar)[XB_TMO])) break; if (_sp > XB_SPIN_CAP) { atomicAdd(&(bar)[XB_TMO], 1u); break; } } } } while (0)
DI void xcd_post(unsigned* bar) { if (threadIdx.x == 0) (void)xb_add(&bar[XB_XCNT(xb_xcc_id())], 1u); }
DI void xcd_complete(unsigned* bar, unsigned x, unsigned& nloc, unsigned& nx) {
    const unsigned G = gridDim.x;
    unsigned sum, cnt, mine, sp = 0u;
    for (;;) {
        sum = 0u; cnt = 0u; mine = 0u;
#pragma unroll
        for (unsigned j = 0; j < 16; ++j) { const unsigned c = xb_ld(&bar[XB_XCNT(j)]); sum += c; cnt += (c > 0u) ? 1u : 0u; mine = (j == x) ? c : mine; }
        if (sum == G) break;
        __builtin_amdgcn_s_sleep(1);
        if ((++sp & 255u) == 0u) { if (xb_ld(&bar[XB_TMO])) break; if (sp > XB_SPIN_CAP) { atomicAdd(&bar[XB_TMO], 1u); break; } }
    }
    nloc = mine > 0u ? mine : 1u; nx = cnt > 0u ? cnt : 1u;
}
DI void xcd_barrier(unsigned* bar, volatile LAS unsigned* st) {
    asm volatile("s_waitcnt vmcnt(0)" ::: "memory");
    __syncthreads();
    if (threadIdx.x == 0) {
        const unsigned x = xb_xcc_id();
        __builtin_amdgcn_s_waitcnt(0);
        unsigned nloc = st[0], nx = st[1];
        if (nloc == 0u) { xcd_complete(bar, x, nloc, nx); st[0] = nloc; st[1] = nx; }
        const unsigned old = xb_add(&bar[XB_XSUB(x)], 1u);
        const unsigned gen = old / nloc;
        if (old + 1u == (gen + 1u) * nloc) {
            __builtin_amdgcn_fence(__ATOMIC_RELEASE, "agent");
            asm volatile("s_waitcnt vmcnt(0)" ::: "memory");
            const unsigned og = xb_add(&bar[XB_TOP], 1u);
            const unsigned tg = og / nx;
            if (og + 1u == (tg + 1u) * nx) xb_add(&bar[XB_TOPGEN], 1u);
            else XB_SPIN(xb_ld(&bar[XB_TOPGEN]) == tg, bar);
            __builtin_amdgcn_fence(__ATOMIC_ACQUIRE, "agent");
            xb_add(&bar[XB_XGEN(x)], 1u);
            asm volatile("s_waitcnt vmcnt(0)" ::: "memory");
        } else {
            XB_SPIN(xb_ld(&bar[XB_XGEN(x)]) == gen, bar);
            __builtin_amdgcn_fence(__ATOMIC_ACQUIRE, "agent");
            asm volatile("s_waitcnt vmcnt(0)" ::: "memory");
        }
    }
    __syncthreads();
}

DI void gbar(unsigned* bar, unsigned target) {
    asm volatile("s_waitcnt vmcnt(0)" ::: "memory");
    __syncthreads();
    if (threadIdx.x == 0) {
        __builtin_amdgcn_fence(__ATOMIC_RELEASE, "agent");
        asm volatile("s_waitcnt vmcnt(0)" ::: "memory");
        __hip_atomic_fetch_add(bar, 1u, __ATOMIC_RELAXED, __HIP_MEMORY_SCOPE_AGENT);
        while (__hip_atomic_load(bar, __ATOMIC_RELAXED, __HIP_MEMORY_SCOPE_AGENT) < target) __builtin_amdgcn_s_sleep(1);
        __builtin_amdgcn_fence(__ATOMIC_ACQUIRE, "agent");
        asm volatile("s_waitcnt vmcnt(0)" ::: "memory");
    }
    __syncthreads();
}

constexpr int NPH = 1 + 16 * NLAYER;
DI void run_phase(const Params& P, int ph, unsigned char* shm, const int rep) {
    unsigned char* ws = P.ws();
    bf16_t* z = (bf16_t*)(ws + WS_Z); bf16_t* h = (bf16_t*)(ws + WS_H); bf16_t* tmp = (bf16_t*)(ws + WS_TMP);
    const int l = ph == 0 ? 0 : (ph - 1) / 16, s = ph == 0 ? -1 : (ph - 1) % 16;
    const bool more = l + 1 < NLAYER;
    if (s == -1) init_phase(P, shm);
    if (s == 8 || s == 12 || s == 15) {
        const int gi_post = s == 8 ? 6 : (s == 12 ? 24 : 30), gi_pre = s == 8 ? 23 : (s == 12 ? 29 : 5);
        const bool has_pre = s != 15 || more;
        norm_res(P, s == 8 && l == 0, tmp, P.in(gi_post) + l * DM, has_pre ? P.in(gi_pre) + (s == 15 ? l + 1 : l) * DM : nullptr, h);
    }
    { int jlo = 0, jhi = 0, lw = l;
      if (s == -1) { jhi = 10; } else if (s == 8) { jlo = 10; jhi = 13; } else if (s == 15 && more) { jhi = 10; lw = l + 1; }
      if (jhi > jlo) convert_jobs(P, lw, jlo, jhi, shm); }
    if (s == -1) norm_rows(P, T, 0, P.in(5), h);
    if (s == -1 || (s == 15 && more)) norm_rows(P, 768, 1, P.in(25) + (s == -1 ? 0 : l + 1) * DM, (bf16_t*)(ws + WS_MEMN));
    if (s == 1) prep_phase(P, l);
    { const int ng = (s == 0 || s == 2) ? 2 : ((s == 6 || s == 7 || s == 9 || s == 11 || s == 13 || s == 14) ? 1 : 0);
#pragma nounroll
      for (int gi = 0; gi < ng; ++gi) {
          unsigned char* w = P.ws();
          bf16_t* zz = (bf16_t*)(w + WS_Z); bf16_t* hh = (bf16_t*)(w + WS_H); bf16_t* tt = (bf16_t*)(w + WS_TMP);
          GD d; gd_set(d, hh, DM, (const bf16_t*)(w + W1_MIX), T, DM, DM, tt, DM);
          switch (s * 2 + gi) {
          case 0: gd_set(d, hh, DM, (const bf16_t*)(w + W1_IN), T, LDZ, DM, zz, LDZ, 0, ZC_G); break;
          case 1: gd_set(d, (const bf16_t*)(w + WS_MEMN), DM, (const bf16_t*)(w + W1_XKV), 768, 1024, DM, (bf16_t*)(w + WS_MEMKV), 1024); d.coff = (int)gridDim.x / 2; break;
          case 4: gd_set(d, zz + ZC_CQA, LDZ, (const bf16_t*)(w + W1_CQ), T, 1536, 512, (bf16_t*)(w + WS_CQ), 1536); break;
          case 5: gd_set(d, zz + ZC_CKVA, LDZ, (const bf16_t*)(w + W1_CKV), T, 2048, 256, hh, 2048); break;
          case 12: gd_set(d, (const bf16_t*)(w + WS_O), 3072, (const bf16_t*)(w + W1_BR), T, DM, 1024, hh, DM, 2); d.nseg = 3; d.segA = 1024; d.segB = (long)2048 * 1024; d.Z = zz; break;
          case 18: gd_set(d, hh, DM, (const bf16_t*)(w + W1_XQ), T, 512, DM, (bf16_t*)(w + WS_XQ), 512); break;
          case 22: gd_set(d, (const bf16_t*)(w + WS_XATT), 512, (const bf16_t*)(w + W1_XOUT), T, DM, 512, tt, DM); break;
          case 26: gd_set(d, hh, DM, (const bf16_t*)(w + W2_GU), T, 2 * DFF, DM, (bf16_t*)(w + WS_U), DFF, 1); break;
          case 28: gd_set(d, (const bf16_t*)(w + WS_U), DFF, (const bf16_t*)(w + W2_DN), T, DM, DFF, tt, DM); break;
          default: break;
          }
          run_gemm(fresh_tid(P), shm, d); }
    }
    if (s == 3) attn_phase<0>(P, l, shm, rep);
    if (s == 3) attn_phase<1>(P, l, shm, rep);
    if (s == 3 || s == 10) attn_phase<2>(P, l, shm, rep, s == 10);
}

__global__ __launch_bounds__(NTHR, 2) void mega(KArgs A, int ph_lo, int ph_hi) {
    extern __shared__ __attribute__((aligned(16))) unsigned char shm[];
    cg::grid_group grid = cg::this_grid();
    { LAS unsigned long long* pt = (LAS unsigned long long*)(shm + PTAB_OFF);
#pragma unroll
      for (int i = 0; i < 34; ++i) if (threadIdx.x == i) pt[i] = (unsigned long long)A.in[i];
      if (threadIdx.x == 34) pt[34] = (unsigned long long)A.out;
      if (threadIdx.x == 35) pt[35] = (unsigned long long)A.ws;
      if (threadIdx.x == 36) { ((LAS unsigned*)(shm + PTAB_OFF + 384))[0] = 0u; ((LAS unsigned*)(shm + PTAB_OFF + 384))[1] = 0u; }
      __syncthreads(); }
    Params P; P.t = (LAS const unsigned long long*)(shm + PTAB_OFF);
    volatile LAS unsigned* xst = (volatile LAS unsigned*)(shm + PTAB_OFF + 384);
    const int wave_s = __builtin_amdgcn_readfirstlane((int)(threadIdx.x >> 6));
    int nbar = 0;
    for (int ph = ph_lo; ph < ph_hi; ++ph) {
        if (ph > 0 && (((ph - 1) % 16) == 4 || ((ph - 1) % 16) == 5)) continue;
        const int nrep = (REP_MASK != 0 && ph > 0 && ((REP_MASK >> ((ph - 1) % 16)) & 1)) ? 2 : 1;
        for (int rep = 0; rep < nrep; ++rep) {
            if (ph > ph_lo || rep > 0) { unsigned* xbw = (unsigned*)(P.ws() + WS_XB); if (nbar == 0) { grid.sync(); xcd_post(xbw); } else xcd_barrier(xbw, xst); ++nbar; }
            { int l_; asm volatile("v_mbcnt_lo_u32_b32 %0, -1, 0\n\tv_mbcnt_hi_u32_b32 %0, -1, %0" : "=v"(l_)); P.tid = wave_s * 64 + l_; }
            run_phase(P, ph, shm, rep);
        }
    }
}

extern "C" void kernel_launch(void* const* d_in, const int* in_sizes, int n_in, void* d_out, int out_size, void* d_ws, size_t ws_size, hipStream_t stream) {
    static int grid = 0;
    if (grid == 0) {
        if (n_in != 34 || out_size != T * DM || ws_size < WS_END) { fprintf(stderr, "kernel_launch: unexpected shapes n_in %d out %d ws %zu (need %zu)\n", n_in, out_size, ws_size, (size_t)WS_END); grid = -1; return; }
        if (hipFuncSetAttribute((const void*)mega, hipFuncAttributeMaxDynamicSharedMemorySize, LDS_BYTES) != hipSuccess) { fprintf(stderr, "kernel_launch: hipFuncSetAttribute failed\n"); grid = -1; return; }
        int dev = 0, cus = 0, per_cu = 0;
        hipGetDevice(&dev); hipDeviceGetAttribute(&cus, hipDeviceAttributeMultiprocessorCount, dev);
        hipOccupancyMaxActiveBlocksPerMultiprocessor(&per_cu, (const void*)mega, NTHR, LDS_BYTES);
        if (per_cu < 1) { fprintf(stderr, "kernel_launch: occupancy query says %d\n", per_cu); per_cu = 1; }
        (void)hipGetLastError();
        grid = cus;
    }
    if (grid < 0) return;
    KArgs p{};
    for (int i = 0; i < 34; ++i) p.in[i] = (const float*)d_in[i];
    p.out = (float*)d_out; p.ws = (unsigned char*)d_ws;
#if ONE_LAUNCH
    int lo = 0, hi = NPH; void* args[] = {&p, &lo, &hi};
    hipError_t e = hipLaunchCooperativeKernel((const void*)mega, dim3(grid), dim3(NTHR), args, LDS_BYTES, stream);
    if (e != hipSuccess) fprintf(stderr, "cooperative launch failed: %s (grid %d)\n", hipGetErrorString(e), grid);
#else
    for (int ph = 0; ph < NPH; ++ph) hipLaunchKernelGGL(mega, dim3(grid), dim3(NTHR), LDS_BYTES, stream, p, ph, ph + 1);
#endif
}
```

```cpp
#include <hip/hip_runtime.h>
#include <hip/hip_cooperative_groups.h>
#include <cstdio>
#include <cstdint>
#include <type_traits>
namespace cg = cooperative_groups;

#ifndef REP_MASK
#define REP_MASK 0
#endif
#ifndef ATT_DMA
#define ATT_DMA 1
#endif
#ifndef NQR_C
#define NQR_C 4
#endif
#ifndef PIPE2_MODES
#define PIPE2_MODES 0
#endif
#ifndef ONE_LAUNCH
#define ONE_LAUNCH 1
#endif

typedef unsigned short bf16_t;
typedef short bf16x8 __attribute__((ext_vector_type(8)));
typedef short s16x4 __attribute__((ext_vector_type(4)));
typedef float f32x2 __attribute__((ext_vector_type(2)));
typedef float f32x4 __attribute__((ext_vector_type(4)));
typedef float f32x16 __attribute__((ext_vector_type(16)));
typedef unsigned u32x2 __attribute__((ext_vector_type(2)));
typedef unsigned u32x4 __attribute__((ext_vector_type(4)));
#define LAS __attribute__((address_space(3)))
#define DI __device__ __forceinline__

constexpr int T = 16384, DM = 2048, LDZ = 11776, NIN = 11584, DFF = 5632, NLAYER = 2;
constexpr int ZC_AQ = 0, ZC_AK = 1024, ZC_AV = 2048, ZC_BQ = 3072, ZC_BK = 4096, ZC_BV = 4352, ZC_CQA = 4608, ZC_CKVA = 5120, ZC_CKR = 5376, ZC_G = 5440;
constexpr float EPS = 1e-6f, LOG2E = 1.4426950408889634f;
constexpr int NTHR = 512;
constexpr int LDS_BYTES = 152064 + 512;
constexpr int NOSIG = 0x7fffffff;

constexpr size_t W1_IN = 0;
constexpr size_t W1_CQ = W1_IN + (size_t)LDZ * 2048 * 2;
constexpr size_t W1_CKV = W1_CQ + (size_t)1536 * 512 * 2;
constexpr size_t W1_BR = W1_CKV + (size_t)2048 * 256 * 2;
constexpr size_t W1_MIX = W1_BR + (size_t)3 * 2048 * 1024 * 2;
constexpr size_t W1_XQ = W1_MIX + (size_t)2048 * 2048 * 2;
constexpr size_t W1_XKV = W1_XQ + (size_t)512 * 2048 * 2;
constexpr size_t W1_XOUT = W1_XKV + (size_t)1024 * 2048 * 2;
constexpr size_t W1_END = W1_XOUT + (size_t)2048 * 512 * 2;
constexpr size_t WS_Z = W1_END;
constexpr size_t WS_XQ = WS_Z, WS_XATT = WS_Z + (size_t)T * 512 * 2, WS_U = WS_Z;
constexpr size_t WS_H = WS_Z + (size_t)T * LDZ * 2;
constexpr size_t WS_O = WS_H + (size_t)T * 2048 * 2;
constexpr size_t WS_TMP = WS_O;
constexpr size_t W2_GU = WS_O + (size_t)T * 2048 * 2;
constexpr size_t W2_DN = W2_GU + (size_t)11264 * 2048 * 2;
constexpr size_t WS_CQ = WS_O + (size_t)T * 3072 * 2;
constexpr size_t WS_OEND = WS_CQ + (size_t)T * 1536 * 2;
static_assert(W2_DN + (size_t)2048 * 5632 * 2 <= WS_OEND, "W2 fits");
constexpr size_t WS_ROPE = WS_OEND;
constexpr size_t WS_MEMN = WS_ROPE + (size_t)8192 * 32 * 8;
constexpr size_t WS_MEMKV = WS_MEMN + (size_t)768 * 2048 * 2;
constexpr size_t WS_CTL = WS_MEMKV + (size_t)768 * 1024 * 2;
constexpr size_t WS_XB = WS_CTL + 256;
constexpr size_t WS_X16 = WS_XB + 16384;
constexpr size_t WS_END = WS_X16 + (size_t)T * 2048 * 2;
static_assert(WS_END <= (size_t)4 * 2 * 2048 * 11584 * 4, "workspace budget: 4 x the largest input (w_in)");

struct KArgs { const float* in[34]; float* out; unsigned char* ws; };
struct Params {
    LAS const unsigned long long* t; int tid;
    DI unsigned long long ld(int i) const { const unsigned long long v = t[i]; const unsigned lo = __builtin_amdgcn_readfirstlane((unsigned)v), hi = __builtin_amdgcn_readfirstlane((unsigned)(v >> 32)); return ((unsigned long long)hi << 32) | lo; }
    DI void* gp(int i) const { return (void*)(__attribute__((address_space(1))) void*)ld(i); }
    DI const float* in(int i) const { return (const float*)gp(i); }
    DI float* out() const { return (float*)gp(34); }
    DI unsigned char* ws() const { return (unsigned char*)gp(35); }
};
constexpr int PTAB_OFF = 152064;

DI unsigned cvtpk(float lo, float hi) { unsigned r; asm volatile("v_cvt_pk_bf16_f32 %0, %1, %2" : "=v"(r) : "v"(lo), "v"(hi)); return r; }
DI float bf2f(unsigned short b) { return __uint_as_float(((unsigned)b) << 16); }
DI float bflo(unsigned w) { return __uint_as_float(w << 16); }
DI float bfhi(unsigned w) { return __uint_as_float(w & 0xffff0000u); }
DI unsigned short f2bf(float f) { return (unsigned short)(cvtpk(f, f) & 0xffffu); }
template <int M> DI float sx(float v) { return __int_as_float(__builtin_amdgcn_ds_swizzle(__float_as_int(v), (M << 10) | 0x1f)); }
DI float half_sum(float v) { v += sx<16>(v); v += sx<8>(v); v += sx<4>(v); v += sx<2>(v); v += sx<1>(v); return v; }
DI float wave_sum(float v) { v = half_sum(v); auto rr = __builtin_amdgcn_permlane32_swap(__float_as_uint(v), __float_as_uint(v), false, false); return __uint_as_float(rr[0]) + __uint_as_float(rr[1]); }
DI float fsigmoid(float x) { return __builtin_amdgcn_rcpf(1.f + __expf(-x)); }
DI int fresh_tid(const Params& P) { int t = P.tid; asm volatile("" : "+v"(t)); return t; }
DI const float* xin_row(const Params& P, int t) { return t < 8192 ? P.in(0) + (size_t)t * DM : P.in(1) + (size_t)(t - 8192) * DM; }

namespace pg8 {
constexpr int BM = 256, BK = 64, HALF = 128, HTB = HALF * BK * 2, STAGE_BYTES = 8 * HTB, NXCD = 8, WGM = 8;
DI int lds_byte(int r, int c) { const int st = (r >> 4) * 2 + (c >> 5), rr = r & 15, cc = c & 31, ob = rr * 64 + cc * 2; return st * 1024 + (ob ^ (((ob >> 9) & 1) << 5)); }
DI void stage_rc(int b, int& R, int& C) { const int st = b / 1024, sb = b % 1024, swz = sb ^ (((sb >> 9) & 1) << 5); R = (st >> 1) * 16 + swz / 64; C = (st & 1) * 32 + (swz % 64) / 2; }
DI int perm32(int rho) { const int n = rho >> 4, i = rho & 15; return 8 * (i >> 2) + 4 * n + (i & 3); }

struct Unit { int pm, pn, seg; };
struct Gemm { const bf16_t* A; const bf16_t* Bt; int M, N, K, lda, nseg; long segA, segB; };

struct Order {
    int nM, nN, nwg, G, c, nseg;
    DI void init(int M, int N, int nseg_, int G_, int c_) { nM = M / BM; nN = N / BM; nwg = nM * nN; G = G_; c = c_; nseg = nseg_; }
    DI bool next(int i, Unit& u) const {
        const int rd = i / nseg; u.seg = i - rd * nseg;
        const long L = (long)rd * G + c; if (L >= nwg) return false;
        int wgid = (int)L; { const int q = nwg / NXCD, r = nwg % NXCD, xcd = wgid % NXCD, off = wgid / NXCD; wgid = (xcd < r ? xcd * (q + 1) : r * (q + 1) + (xcd - r) * q) + off; }
        const int nig = WGM * nN, gid = wgid / nig, fm = gid * WGM, gsz = (nM - fm) < WGM ? (nM - fm) : WGM;
        u.pm = fm + ((wgid % nig) % gsz); u.pn = (wgid % nig) / gsz; return true;
    }
};

template <class Epi>
DI void gemm_phase(LAS unsigned char* lds, const Gemm g, const Order& S, const Epi& E, const int tid) {
    const int wid = __builtin_amdgcn_readfirstlane(tid >> 6), lane = tid & 63, wr = wid >> 2, wc = wid & 3, fr = lane & 15, fq = lane >> 4;
    const int K = g.K, nt = K / BK;
    unsigned voffA[2], voffB[2];
#pragma unroll
    for (int i = 0; i < 2; ++i) { int R, C; stage_rc(tid * 16 + i * 8192, R, C); const int Rb = (R & ~31) + perm32(R & 31);
        voffA[i] = (unsigned)(R * g.lda + C) * 2u; voffB[i] = (unsigned)(Rb * K + C) * 2u; }
    const size_t kstep = (size_t)(BK * 2);
    const size_t hstepA = (size_t)HALF * g.lda * 2, hstepB = (size_t)HALF * K * 2;
    const size_t tstepA = 2 * hstepA, tstepB = 2 * hstepB;
    const unsigned ldsw = (unsigned)wid * 1024u;
    const int aoff = lds_byte(wr * 64 + fr, fq * 8), boff = lds_byte(wc * 32 + fr, fq * 8);
#define PG8_SA(b, h) (((b) * 2 + (h)) * HTB)
#define PG8_SB(b, h) ((4 + (b) * 2 + (h)) * HTB)
#define PG8_STAGE(bufoff, gbase, voff) do { _Pragma("unroll") for (int _i = 0; _i < 2; ++_i) \
        __builtin_amdgcn_global_load_lds((const unsigned*)((const char*)(gbase) + (voff)[_i]), (LAS unsigned*)(lds + (bufoff) + ldsw + _i * 8192), 16, 0, 0); } while (0)
#define PG8_LDA(dst, b, h) do { _Pragma("unroll") for (int m = 0; m < 4; ++m) _Pragma("unroll") for (int k = 0; k < 2; ++k) dst[m][k] = *(const LAS bf16x8*)(lds + PG8_SA(b, h) + aoff + m * 2048 + k * 1024); } while (0)
#define PG8_LDB(dst, b, h) do { _Pragma("unroll") for (int n = 0; n < 2; ++n) _Pragma("unroll") for (int k = 0; k < 2; ++k) dst[n][k] = *(const LAS bf16x8*)(lds + PG8_SB(b, h) + boff + n * 2048 + k * 1024); } while (0)
#define PG8_MMA(ai, bj, At, Bt) do { __builtin_amdgcn_s_setprio(1); _Pragma("unroll") for (int m = 0; m < 4; ++m) _Pragma("unroll") for (int n = 0; n < 2; ++n) _Pragma("unroll") for (int k = 0; k < 2; ++k) \
        acc[ai][bj][m][n] = __builtin_amdgcn_mfma_f32_16x16x32_bf16(Bt[n][k], At[m][k], acc[ai][bj][m][n], 0, 0, 0); __builtin_amdgcn_s_setprio(0); } while (0)
#define PG8_WAIT_V(n) asm volatile("s_waitcnt vmcnt(" #n ")" ::: "memory")
#define PG8_WAIT_L(n) asm volatile("s_waitcnt lgkmcnt(" #n ")" ::: "memory")
#define PG8_BAR __builtin_amdgcn_s_barrier()
#define PG8_SCHED __builtin_amdgcn_sched_barrier(0)
    Unit cur, nxt; int ui = 0;
    if (!S.next(0, cur)) return;
    f32x4 acc[2][2][4][2];
#pragma unroll
    for (int a = 0; a < 2; ++a)
#pragma unroll
        for (int b = 0; b < 2; ++b)
#pragma unroll
            for (int m = 0; m < 4; ++m)
#pragma unroll
                for (int n = 0; n < 2; ++n) acc[a][b][m][n] = (f32x4){0.f, 0.f, 0.f, 0.f};
    bf16x8 At[4][2], B0[2][2], B1[2][2];
    const char* cA = (const char*)(g.A + cur.seg * g.segA) + (size_t)cur.pm * tstepA; const char* cB = (const char*)(g.Bt + cur.seg * g.segB) + (size_t)cur.pn * tstepB;
    PG8_STAGE(PG8_SB(0, 0), cB, voffB); PG8_STAGE(PG8_SA(0, 0), cA, voffA); PG8_STAGE(PG8_SB(0, 1), cB + hstepB, voffB); PG8_STAGE(PG8_SA(0, 1), cA + hstepA, voffA);
    if (wr == 1) PG8_BAR;
    PG8_WAIT_V(4); PG8_BAR;
    PG8_STAGE(PG8_SB(1, 0), cB + kstep, voffB); PG8_STAGE(PG8_SA(1, 0), cA + kstep, voffA); PG8_STAGE(PG8_SB(1, 1), cB + hstepB + kstep, voffB);
    PG8_WAIT_V(6); PG8_BAR;
    for (;;) {
        const bool has_next = S.next(ui + 1, nxt);
        const char* nA = has_next ? (const char*)(g.A + nxt.seg * g.segA) + (size_t)nxt.pm * tstepA : cA;
        const char* nB = has_next ? (const char*)(g.Bt + nxt.seg * g.segB) + (size_t)nxt.pn * tstepB : cB;
        for (int t = 0; t < nt; t += 2) {
            const bool last = (t == nt - 2);
            const char* a1 = cA + (size_t)(t + 1) * kstep;
            const char* a2 = last ? nA : cA + (size_t)(t + 2) * kstep; const char* b2 = last ? nB : cB + (size_t)(t + 2) * kstep;
            const char* a3 = a2 + kstep; const char* b3 = b2 + kstep;
            PG8_LDB(B0, 0, 0); PG8_SCHED; PG8_LDA(At, 0, 0); PG8_STAGE(PG8_SA(1, 1), a1 + hstepA, voffA);
            PG8_WAIT_L(8); PG8_BAR; PG8_WAIT_L(0); PG8_MMA(0, 0, At, B0); PG8_BAR; PG8_SCHED;
            PG8_LDB(B1, 0, 1); PG8_STAGE(PG8_SB(0, 0), b2, voffB);
            PG8_BAR; PG8_WAIT_L(0); PG8_MMA(0, 1, At, B1); PG8_BAR;
            PG8_LDA(At, 0, 1); PG8_STAGE(PG8_SA(0, 0), a2, voffA);
            PG8_BAR; PG8_WAIT_L(0); PG8_MMA(1, 0, At, B0); PG8_BAR; PG8_SCHED;
            PG8_STAGE(PG8_SB(0, 1), b2 + hstepB, voffB);
            PG8_WAIT_V(6); PG8_BAR; PG8_MMA(1, 1, At, B1); PG8_BAR;
            PG8_LDB(B0, 1, 0); PG8_SCHED; PG8_LDA(At, 1, 0); PG8_STAGE(PG8_SA(0, 1), a2 + hstepA, voffA);
            PG8_WAIT_L(8); PG8_BAR; PG8_WAIT_L(0); PG8_MMA(0, 0, At, B0); PG8_BAR; PG8_SCHED;
            PG8_LDB(B1, 1, 1); PG8_STAGE(PG8_SB(1, 0), b3, voffB);
            PG8_BAR; PG8_WAIT_L(0); PG8_MMA(0, 1, At, B1); PG8_BAR;
            PG8_LDA(At, 1, 1); PG8_STAGE(PG8_SA(1, 0), a3, voffA);
            PG8_BAR; PG8_WAIT_L(0); PG8_MMA(1, 0, At, B0); PG8_BAR; PG8_SCHED;
            PG8_STAGE(PG8_SB(1, 1), b3 + hstepB, voffB);
            PG8_WAIT_V(6); PG8_BAR; PG8_MMA(1, 1, At, B1); PG8_BAR;
        }
        E(acc, cur, wr, wc, fr, fq);
        if (!has_next) break;
#pragma unroll
        for (int a = 0; a < 2; ++a)
#pragma unroll
            for (int b = 0; b < 2; ++b)
#pragma unroll
                for (int m = 0; m < 4; ++m)
#pragma unroll
                    for (int n = 0; n < 2; ++n) acc[a][b][m][n] = (f32x4){0.f, 0.f, 0.f, 0.f};
        cur = nxt; cA = nA; cB = nB; ++ui;
    }
    PG8_WAIT_V(0);
    if (wr == 0) PG8_BAR;
    PG8_BAR;
#undef PG8_SA
#undef PG8_SB
#undef PG8_STAGE
#undef PG8_LDA
#undef PG8_LDB
#undef PG8_MMA
#undef PG8_WAIT_V
#undef PG8_WAIT_L
#undef PG8_BAR
#undef PG8_SCHED
}

DI u32x4 pack8(f32x4 v0, f32x4 v1) { u32x4 w; w.x = cvtpk(v0[0], v0[1]); w.y = cvtpk(v0[2], v0[3]); w.z = cvtpk(v1[0], v1[1]); w.w = cvtpk(v1[2], v1[3]); return w; }
struct EpiAny {
    int mode; bf16_t* O; int ldc; int sigc; const bf16_t* Z;
    DI void operator()(const f32x4 (&acc)[2][2][4][2], const Unit& u, int wr, int wc, int fr, int fq) const {
        const int row0 = u.pm * BM + wr * 64 + fr;
        if (mode == 0) {
            const int col0 = u.pn * BM + wc * 32 + 8 * fq;
#pragma unroll
            for (int ai = 0; ai < 2; ++ai)
#pragma unroll
                for (int m = 0; m < 4; ++m) { bf16_t* rowp = O + (size_t)(row0 + ai * HALF + m * 16) * ldc + col0;
#pragma unroll
                    for (int bj = 0; bj < 2; ++bj) { f32x4 v0 = acc[ai][bj][m][0], v1 = acc[ai][bj][m][1];
                        if (col0 + bj * HALF >= sigc) {
#pragma unroll
                            for (int j = 0; j < 4; ++j) { v0[j] = fsigmoid(v0[j]); v1[j] = fsigmoid(v1[j]); } }
                        *(u32x4*)(rowp + bj * HALF) = pack8(v0, v1); } }
        } else if (mode == 1) {
            const int col0 = u.pn * HALF + wc * 32 + 8 * fq;
#pragma unroll
            for (int ai = 0; ai < 2; ++ai)
#pragma unroll
                for (int m = 0; m < 4; ++m) { bf16_t* rowp = O + (size_t)(row0 + ai * HALF + m * 16) * ldc + col0;
                    f32x4 v0, v1;
#pragma unroll
                    for (int j = 0; j < 4; ++j) { const float g0 = acc[ai][0][m][0][j], g1 = acc[ai][0][m][1][j];
                        v0[j] = g0 * fsigmoid(g0) * acc[ai][1][m][0][j]; v1[j] = g1 * fsigmoid(g1) * acc[ai][1][m][1][j]; }
                    *(u32x4*)rowp = pack8(v0, v1); }
        } else {
            const int col0 = u.pn * BM + wc * 32 + 8 * fq;
#pragma unroll
            for (int ai = 0; ai < 2; ++ai)
#pragma unroll
                for (int m = 0; m < 4; ++m) { const int row = row0 + ai * HALF + m * 16; bf16_t* rowp = O + (size_t)row * DM + col0;
                    const bf16_t* gp = Z + (size_t)row * LDZ + ZC_G + u.seg * DM + col0;
#pragma unroll
                    for (int bj = 0; bj < 2; ++bj) { const u32x4 gw = *(const u32x4*)(gp + bj * HALF);
                        f32x4 v0 = acc[ai][bj][m][0], v1 = acc[ai][bj][m][1];
                        v0[0] *= bflo(gw.x); v0[1] *= bfhi(gw.x); v0[2] *= bflo(gw.y); v0[3] *= bfhi(gw.y);
                        v1[0] *= bflo(gw.z); v1[1] *= bfhi(gw.z); v1[2] *= bflo(gw.w); v1[3] *= bfhi(gw.w);
                        if (u.seg > 0) { const u32x4 pw = *(const u32x4*)(rowp + bj * HALF);
                            v0[0] += bflo(pw.x); v0[1] += bfhi(pw.x); v0[2] += bflo(pw.y); v0[3] += bfhi(pw.y);
                            v1[0] += bflo(pw.z); v1[1] += bfhi(pw.z); v1[2] += bflo(pw.w); v1[3] += bfhi(pw.w); }
                        *(u32x4*)(rowp + bj * HALF) = pack8(v0, v1); } }
        }
    }
};
}

struct GD { const bf16_t* A; const bf16_t* Bt; bf16_t* O; const bf16_t* Z; int lda, M, N, K, ldc, sigc, mode, nseg, coff; long segA, segB; };
DI void gd_set(GD& d, const bf16_t* A, int lda, const bf16_t* Bt, int M, int N, int K, bf16_t* O, int ldc, int mode = 0, int sigc = NOSIG) {
    d.A = A; d.lda = lda; d.Bt = Bt; d.M = M; d.N = N; d.K = K; d.O = O; d.ldc = ldc; d.mode = mode; d.sigc = sigc; d.nseg = 1; d.segA = 0; d.segB = 0; d.Z = nullptr; d.coff = 0; }
DI void run_gemm(const int tid, unsigned char* shm, const GD& d) {
    pg8::Gemm g; g.A = d.A; g.Bt = d.Bt; g.M = d.M; g.N = d.N; g.K = d.K; g.lda = d.lda; g.nseg = d.nseg; g.segA = d.segA; g.segB = d.segB;
    pg8::EpiAny E; E.mode = d.mode; E.O = d.O; E.ldc = d.ldc; E.sigc = d.sigc; E.Z = d.Z;
    pg8::Order S; S.init(d.M, d.N, d.nseg, (int)gridDim.x, (int)((blockIdx.x + d.coff) % gridDim.x));
    pg8::gemm_phase<pg8::EpiAny>((LAS unsigned char*)shm, g, S, E, tid);
}

#define SBAR() __builtin_amdgcn_sched_barrier(0)
DI int crow(int r, int hi) { return (r & 3) + 8 * (r >> 2) + 4 * hi; }
DI int v_st(int k, int c) { const int kk = (k & ~0xC) | ((k & 4) << 1) | ((k & 8) >> 1); return ((kk >> 3) * 4 + (c >> 5)) * 512 + ((kk & 7) * 32 + (c & 31)) * 2; }
DI int v_rd_base(int lane) { return ((lane & 3) << 3) | (((lane >> 2) & 3) << 6) | (((lane >> 4) & 1) << 5) | (((lane >> 5) & 1) << 8); }
constexpr int v_rd_off(int d0, int ks, int half) { return d0 * 512 + ks * 4096 + half * 2048; }
template <int OFF> DI s16x4 tr_read(int vb) { s16x4 r; asm volatile("ds_read_b64_tr_b16 %0, %1 offset:%2" : "=&v"(r) : "v"(vb), "i"(OFF) : "memory"); return r; }
template <int I, int N, class F> DI void cfor(F&& f) { if constexpr (I < N) { f(std::integral_constant<int, I>{}); cfor<I + 1, N>(f); } }
template <int OFF> DI void dsr128(bf16x8& r, int addr) { asm volatile("ds_read_b128 %0, %1 offset:%2" : "=&v"(r) : "v"(addr), "i"(OFF) : "memory"); }
template <int N> DI void wait_lgkm() { asm volatile("s_waitcnt lgkmcnt(%0)" :: "i"(N) : "memory"); }
template <int KS> DI void v_rd8(s16x4* f, int vb) {
    f[0] = tr_read<v_rd_off(0, KS, 0)>(vb); f[1] = tr_read<v_rd_off(0, KS, 1)>(vb); f[2] = tr_read<v_rd_off(1, KS, 0)>(vb); f[3] = tr_read<v_rd_off(1, KS, 1)>(vb);
    f[4] = tr_read<v_rd_off(2, KS, 0)>(vb); f[5] = tr_read<v_rd_off(2, KS, 1)>(vb); f[6] = tr_read<v_rd_off(3, KS, 0)>(vb); f[7] = tr_read<v_rd_off(3, KS, 1)>(vb);
}
DI void pv_mm(f32x16* o, const s16x4* f, bf16x8 pa) {
#define PK(L, H) (bf16x8){L[0], L[1], L[2], L[3], H[0], H[1], H[2], H[3]}
    o[0] = __builtin_amdgcn_mfma_f32_32x32x16_bf16(pa, PK(f[0], f[1]), o[0], 0, 0, 0);
    o[1] = __builtin_amdgcn_mfma_f32_32x32x16_bf16(pa, PK(f[2], f[3]), o[1], 0, 0, 0);
    o[2] = __builtin_amdgcn_mfma_f32_32x32x16_bf16(pa, PK(f[4], f[5]), o[2], 0, 0, 0);
    o[3] = __builtin_amdgcn_mfma_f32_32x32x16_bf16(pa, PK(f[6], f[7]), o[3], 0, 0, 0);
#undef PK
}
DI void pv_d0(f32x16* o, int vb, bf16x8 pa0, bf16x8 pa1, bf16x8 pa2, bf16x8 pa3) {
    s16x4 fa[8], fb[8];
    v_rd8<0>(fa, vb);
    v_rd8<1>(fb, vb); wait_lgkm<8>(); SBAR(); pv_mm(o, fa, pa0);
    v_rd8<2>(fa, vb); wait_lgkm<8>(); SBAR(); pv_mm(o, fb, pa1);
    v_rd8<3>(fb, vb); wait_lgkm<8>(); SBAR(); pv_mm(o, fa, pa2);
    wait_lgkm<0>(); SBAR(); pv_mm(o, fb, pa3);
}

DI void pv_d0_s(f32x16* o, int vb, bf16x8 pa0, bf16x8 pa1, bf16x8 pa2, bf16x8 pa3) {
    s16x4 fa[8];
    v_rd8<0>(fa, vb); wait_lgkm<0>(); SBAR(); pv_mm(o, fa, pa0); SBAR();
    v_rd8<1>(fa, vb); wait_lgkm<0>(); SBAR(); pv_mm(o, fa, pa1); SBAR();
    v_rd8<2>(fa, vb); wait_lgkm<0>(); SBAR(); pv_mm(o, fa, pa2); SBAR();
    v_rd8<3>(fa, vb); wait_lgkm<0>(); SBAR(); pv_mm(o, fa, pa3);
}
struct AttnArgs {
    const bf16_t* Q; int ldq;
    const bf16_t* K; int ldk;
    const bf16_t* K2; int ldk2;
    const bf16_t* V; int ldv;
    bf16_t* O; int ldo;
    int seq; float C;
    int qpos0;
    const float* tab;
    const f32x2* rope;
    int map; float lam; const float* ga; float oscale;
    int tid;
};

constexpr float THR_L2 = 8.f * LOG2E;
constexpr int ATT_QR = 86016;
constexpr int ATT_WSC = 2 * 16384 + 2 * 64 * 384;

template <int DQK, int MODE>
DI void attn_body(const AttnArgs& a, char* lds) {
    constexpr int KROWB = DQK * 2, SHM_K = 64 * KROWB, SHM_V = 64 * 128 * 2, KCH = DQK / 64, CPR = DQK / 8, ND0 = DQK / 16, SD = 1;
    int tid = a.tid; asm volatile("" : "+v"(tid));
    const int wid = tid >> 6, lane = tid & 63, r32 = lane & 31, hi = lane >> 5;
    char* V_lds = lds; char* K_lds = lds + 2 * SHM_V;
    float* wsc = (float*)(lds + ATT_WSC) + wid * 64; float* li_l = wsc; float* al_l = wsc + 32;
    constexpr int NQR = (MODE == 2) ? NQR_C : ND0;
    float m_reg = -1e30f, l_reg = 0; f32x16 o[4] = {}; bf16x8 qr[NQR];
    char* qrl = lds + ATT_QR + wid * ((12 - NQR_C) * 1024) + lane * 16;
    const float C = a.C;
    auto ksw = [](int row) { return KROWB == 256 ? (((row & 7) | (((row >> 4) & 1) << 3)) << 4) : (((row >> 1) & 7) << 4); };
    __syncthreads();
    const bf16_t* Qw = a.Q + (size_t)(wid * 32 + r32) * a.ldq + hi * 8;
#pragma unroll
    for (int d0 = 0; d0 < NQR; ++d0) qr[d0] = *(const bf16x8*)(Qw + d0 * 16);
    if constexpr (MODE == 2) {
        const f32x2* rp = a.rope + (size_t)(a.qpos0 + wid * 32 + r32) * 32 + hi * 8;
#pragma unroll
        for (int dd = 0; dd < 2; ++dd) {
            bf16x8 x1 = *(const bf16x8*)(Qw + (8 + dd) * 16), x2 = *(const bf16x8*)(Qw + (10 + dd) * 16); bf16x8 y1, y2;
#pragma unroll
            for (int j = 0; j < 8; ++j) { const f32x2 cs = rp[dd * 16 + j]; const float a1 = bf2f((unsigned short)x1[j]), a2 = bf2f((unsigned short)x2[j]);
                y1[j] = (short)f2bf(a1 * cs.x - a2 * cs.y); y2[j] = (short)f2bf(a1 * cs.y + a2 * cs.x); }
            *(bf16x8*)(qrl + (8 + dd - NQR) * 1024) = y1; *(bf16x8*)(qrl + (10 + dd - NQR) * 1024) = y2; }
#pragma unroll
        for (int d0 = NQR; d0 < 8; ++d0) *(bf16x8*)(qrl + (d0 - NQR) * 1024) = *(const bf16x8*)(Qw + d0 * 16);
    }
    const int sr = tid >> 4, sc = (tid & 15) * 8, vst0 = v_st(sr, sc), vst1 = v_st(32 + sr, sc);
    const bf16_t* vp0 = a.V + (size_t)sr * a.ldv + sc; const bf16_t* vp1 = a.V + (size_t)(32 + sr) * a.ldv + sc;
    const bf16_t* kp[KCH]; int kld[KCH], kdst[KCH];
#pragma unroll
    for (int i = 0; i < KCH; ++i) { const int e = tid + i * NTHR, row = e / CPR, c = e % CPR;
        if (MODE == 2 && c >= 16) { kp[i] = a.K2 + (size_t)row * a.ldk2 + (c - 16) * 8; kld[i] = a.ldk2; }
        else { kp[i] = a.K + (size_t)row * a.ldk + c * 8; kld[i] = a.ldk; }
        kdst[i] = row * KROWB + ((c * 16) ^ ksw(row)); }
    const int vb0 = (int)(uintptr_t)V_lds + v_rd_base(lane);
    struct { bf16x8 vs0, vs1, ks[KCH]; } st_[SD];
#define SLOAD(i, k0) do { st_[i].vs0 = *(const bf16x8*)(vp0 + (size_t)(k0) * a.ldv); st_[i].vs1 = *(const bf16x8*)(vp1 + (size_t)(k0) * a.ldv); \
    _Pragma("unroll") for (int _q = 0; _q < KCH; ++_q) st_[i].ks[_q] = *(const bf16x8*)(kp[_q] + (size_t)(k0) * kld[_q]); } while (0)
#define SWRITE(b, i) do { *(bf16x8*)(V_lds + (b) * SHM_V + vst0) = st_[i].vs0; *(bf16x8*)(V_lds + (b) * SHM_V + vst1) = st_[i].vs1; \
    _Pragma("unroll") for (int _q = 0; _q < KCH; ++_q) *(bf16x8*)(K_lds + (b) * SHM_K + kdst[_q]) = st_[i].ks[_q]; } while (0)
#define SWAIT() do { if constexpr (SD == 2) { if constexpr (KCH == 1) asm volatile("s_waitcnt vmcnt(3)" ::: "memory"); else asm volatile("s_waitcnt vmcnt(4)" ::: "memory"); } \
    else asm volatile("s_waitcnt vmcnt(0)" ::: "memory"); } while (0)
#define RESC(al) do { if (__any((al) < 1.f)) { if (hi == 0) al_l[r32] = (al); asm volatile("s_waitcnt lgkmcnt(0)" ::: "memory"); \
    _Pragma("unroll") for (int d = 0; d < 4; ++d) _Pragma("unroll") for (int r = 0; r < 16; ++r) o[d][r] *= al_l[crow(r, hi)]; } } while (0)
#if ATT_DMA
    constexpr int NI = 2 + KCH;
    const bf16_t* sp[NI]; int sld[NI];
#pragma unroll
    for (int i = 0; i < NI; ++i) { const int b = wid + 8 * i;
        if (i < 2) { const int pos = b * 1024 + lane * 16, stl = pos >> 9, q = (pos & 511) >> 1, kk = (stl >> 2) * 8 + (q >> 5), c = (stl & 3) * 32 + (q & 31);
            const int k = (kk & ~0xC) | ((kk & 4) << 1) | ((kk & 8) >> 1);
            sp[i] = a.V + (size_t)k * a.ldv + c; sld[i] = a.ldv;
        } else { const int pos = (b - 16) * 1024 + lane * 16, row = pos / KROWB, within = pos - row * KROWB, c = (within ^ ksw(row)) >> 4;
            if (MODE == 2 && c >= 16) { sp[i] = a.K2 + (size_t)row * a.ldk2 + (c - 16) * 8; sld[i] = a.ldk2; }
            else { sp[i] = a.K + (size_t)row * a.ldk + c * 8; sld[i] = a.ldk; } } }
    const int wu = __builtin_amdgcn_readfirstlane(wid);
#define DMA(buf, k0) do { _Pragma("unroll") for (int _i = 0; _i < NI; ++_i) { \
        char* _d = (_i < 2) ? V_lds + (buf) * SHM_V + (wu + 8 * _i) * 1024 : K_lds + (buf) * SHM_K + (wu + 8 * _i - 16) * 1024; \
        __builtin_amdgcn_global_load_lds((const unsigned*)(sp[_i] + (size_t)(k0) * sld[_i]), (LAS unsigned*)_d, 16, 0, 0); } } while (0)
#endif
    constexpr int NB = (KROWB == 256) ? 8 : 4;
    int kb[NB];
    { const int X = (hi * 16) ^ ksw(r32);
#pragma unroll
      for (int i = 0; i < NB; ++i) kb[i] = (int)(uintptr_t)K_lds + r32 * KROWB + ((i * 32) ^ X); }
    const int qra = (int)(uintptr_t)qrl;
    auto qkt = [&](f32x16& p0, f32x16& p1, const int kofs) {
        p0 = f32x16{}; p1 = f32x16{};
        int kc[NB];
#pragma unroll
        for (int i = 0; i < NB; ++i) kc[i] = kb[i] + kofs;
        bf16x8 fk[2][2]; bf16x8 fq[2];
        auto rd = [&](auto ic) { constexpr int d0 = decltype(ic)::value; constexpr int sl = d0 & 1;
            dsr128<(d0 / NB) * (NB * 32)>(fk[sl][0], kc[d0 % NB]); dsr128<(d0 / NB) * (NB * 32) + 32 * KROWB>(fk[sl][1], kc[d0 % NB]);
            if constexpr (MODE == 2 && d0 >= NQR) dsr128<(d0 - NQR) * 1024>(fq[sl], qra); };
        rd(std::integral_constant<int, 0>{});
        cfor<0, ND0>([&](auto ic) { constexpr int d0 = decltype(ic)::value; constexpr int sl = d0 & 1;
            if constexpr (d0 + 1 < ND0) { rd(std::integral_constant<int, d0 + 1>{}); wait_lgkm<(MODE == 2 && d0 + 1 >= NQR) ? 3 : 2>(); }
            else wait_lgkm<0>();
            SBAR();
            bf16x8 qf; if constexpr (MODE == 2 && d0 >= NQR) qf = fq[sl]; else qf = qr[d0 < NQR ? d0 : 0];
            p0 = __builtin_amdgcn_mfma_f32_32x32x16_bf16(fk[sl][0], qf, p0, 0, 0, 0);
            p1 = __builtin_amdgcn_mfma_f32_32x32x16_bf16(fk[sl][1], qf, p1, 0, 0, 0); });
    };
    const int qw0 = a.qpos0 + wid * 32;
    auto partialSM = [&](f32x16& p0, f32x16& p1, float& mn, float& alpha, int k0) {
        if constexpr (MODE == 1) {
            const int relmax = k0 + 63 - qw0, relmin = k0 - qw0 - 31;
            if (relmax <= -128 || relmin >= 128) {
                const float bc = a.tab[relmax <= -128 ? 0 : 256];
                float pmax = p0[0];
#pragma unroll
                for (int r = 1; r < 16; ++r) pmax = fmaxf(pmax, p0[r]);
#pragma unroll
                for (int r = 0; r < 16; ++r) pmax = fmaxf(pmax, p1[r]);
                { auto rr = __builtin_amdgcn_permlane32_swap(__float_as_uint(pmax), __float_as_uint(pmax), false, false);
                  pmax = fmaxf(__uint_as_float(rr[0]), __uint_as_float(rr[1])); }
                pmax = fmaf(pmax, C, bc);
                if (__builtin_expect(__all(pmax - m_reg <= THR_L2), 1)) { mn = m_reg; alpha = 1.f; }
                else { mn = fmaxf(m_reg, pmax); alpha = __builtin_amdgcn_exp2f(m_reg - mn); m_reg = mn; }
                const float off = bc - mn;
#pragma unroll
                for (int r = 0; r < 16; ++r) { p0[r] = fmaf(p0[r], C, off); p1[r] = fmaf(p1[r], C, off); }
            } else {
                const int base = k0 - (qw0 + r32) + 4 * hi + 128;
#pragma unroll
                for (int r = 0; r < 16; ++r) { const int i0 = base + (r & 3) + 8 * (r >> 2);
                    const int j0 = min(max(i0, 0), 256), j1 = min(max(i0 + 32, 0), 256);
                    p0[r] = fmaf(p0[r], C, a.tab[j0]); p1[r] = fmaf(p1[r], C, a.tab[j1]); }
                float pmax = p0[0];
#pragma unroll
                for (int r = 1; r < 16; ++r) pmax = fmaxf(pmax, p0[r]);
#pragma unroll
                for (int r = 0; r < 16; ++r) pmax = fmaxf(pmax, p1[r]);
                { auto rr = __builtin_amdgcn_permlane32_swap(__float_as_uint(pmax), __float_as_uint(pmax), false, false);
                  pmax = fmaxf(__uint_as_float(rr[0]), __uint_as_float(rr[1])); }
                if (__builtin_expect(__all(pmax - m_reg <= THR_L2), 1)) { mn = m_reg; alpha = 1.f; }
                else { mn = fmaxf(m_reg, pmax); alpha = __builtin_amdgcn_exp2f(m_reg - mn); m_reg = mn; }
#pragma unroll
                for (int r = 0; r < 16; ++r) { p0[r] -= mn; p1[r] -= mn; }
            }
#pragma unroll
            for (int r = 0; r < 16; ++r) p0[r] = __builtin_amdgcn_exp2f(p0[r]);
        } else {
            float pmax = p0[0];
#pragma unroll
            for (int r = 1; r < 16; ++r) pmax = fmaxf(pmax, p0[r]);
#pragma unroll
            for (int r = 0; r < 16; ++r) pmax = fmaxf(pmax, p1[r]);
            { auto rr = __builtin_amdgcn_permlane32_swap(__float_as_uint(pmax), __float_as_uint(pmax), false, false);
              pmax = fmaxf(__uint_as_float(rr[0]), __uint_as_float(rr[1])); }
            if (__builtin_expect(__all((pmax - m_reg) * C <= THR_L2), 1)) { mn = m_reg; alpha = 1.f; }
            else { mn = fmaxf(m_reg, pmax); alpha = __builtin_amdgcn_exp2f((m_reg - mn) * C); m_reg = mn; }
            const float mnC = -mn * C;
#pragma unroll
            for (int r = 0; r < 16; ++r) { p0[r] = fmaf(p0[r], C, mnC); p1[r] = fmaf(p1[r], C, mnC); }
#pragma unroll
            for (int r = 0; r < 16; ++r) p0[r] = __builtin_amdgcn_exp2f(p0[r]);
        }
    };
    auto finishSM = [&](f32x16& p0, f32x16& p1, float alpha, bf16x8& pa0, bf16x8& pa1, bf16x8& pa2, bf16x8& pa3) {
#pragma unroll
        for (int r = 0; r < 16; ++r) p1[r] = __builtin_amdgcn_exp2f(p1[r]);
        float ps = 0;
#pragma unroll
        for (int r = 0; r < 16; ++r) ps += p0[r];
#pragma unroll
        for (int r = 0; r < 16; ++r) ps += p1[r];
        { auto rr = __builtin_amdgcn_permlane32_swap(__float_as_uint(ps), __float_as_uint(ps), false, false);
          ps = __uint_as_float(rr[0]) + __uint_as_float(rr[1]); }
        l_reg = l_reg * alpha + ps;
#define PK4(P, BASE, OUT) do { unsigned a0 = cvtpk(P[BASE + 0], P[BASE + 1]), a1 = cvtpk(P[BASE + 2], P[BASE + 3]);   \
    unsigned b0 = cvtpk(P[BASE + 4], P[BASE + 5]), b1 = cvtpk(P[BASE + 6], P[BASE + 7]);                              \
    auto r0 = __builtin_amdgcn_permlane32_swap(a0, b0, false, false); auto r1 = __builtin_amdgcn_permlane32_swap(a1, b1, false, false); \
    u32x4 w = {r0[0], r1[0], r0[1], r1[1]}; OUT = *reinterpret_cast<bf16x8*>(&w); } while (0)
        PK4(p0, 0, pa0); PK4(p0, 8, pa1); PK4(p1, 0, pa2); PK4(p1, 8, pa3);
#undef PK4
    };
    bf16x8 pa0, pa1, pa2, pa3; const int NT = a.seq / 64;
    if constexpr ((PIPE2_MODES >> MODE) & 1) {
        auto qkt_c = [&](f32x16& p0, f32x16& p1, const char* Ks) {
            p0 = f32x16{}; p1 = f32x16{};
#pragma unroll
            for (int d0 = 0; d0 < ND0; ++d0) { const int cb = (d0 * 16 + hi * 8) * 2;
                const bf16x8 b0 = *(const bf16x8*)(Ks + r32 * KROWB + (cb ^ ksw(r32)));
                const bf16x8 b1 = *(const bf16x8*)(Ks + (32 + r32) * KROWB + (cb ^ ksw(r32)));
                bf16x8 qf; if constexpr (MODE == 2) { if (d0 >= NQR) qf = *(const bf16x8*)(qrl + (d0 - NQR) * 1024); else qf = qr[d0 < NQR ? d0 : 0]; } else qf = qr[d0];
                p0 = __builtin_amdgcn_mfma_f32_32x32x16_bf16(b0, qf, p0, 0, 0, 0);
                p1 = __builtin_amdgcn_mfma_f32_32x32x16_bf16(b1, qf, p1, 0, 0, 0); }
        };
        f32x16 pA0, pA1, pB0, pB1; float mnA, mnB, alA, alB;
        SLOAD(0, 0); asm volatile("s_waitcnt vmcnt(0)" ::: "memory"); SWRITE(0, 0); __syncthreads();
        qkt_c(pA0, pA1, K_lds); partialSM(pA0, pA1, mnA, alA, 0);
        SLOAD(0, 64);
        SWRITE(1, 0); __syncthreads();
#pragma unroll 1
        for (int j = 1; j + 1 < NT; j += 2) {
            SBAR(); qkt_c(pB0, pB1, K_lds + SHM_K);
            finishSM(pA0, pA1, alA, pa0, pa1, pa2, pa3); SBAR();
            SLOAD(0, (j + 1) * 64); SBAR();
            pv_d0_s(o, vb0, pa0, pa1, pa2, pa3); partialSM(pB0, pB1, mnB, alB, j * 64);
            __syncthreads(); SWRITE(0, 0);
            RESC(alB); __syncthreads();
            SBAR(); qkt_c(pA0, pA1, K_lds);
            finishSM(pB0, pB1, alB, pa0, pa1, pa2, pa3); SBAR();
            SLOAD(0, (j + 2) * 64); SBAR();
            pv_d0_s(o, vb0 + SHM_V, pa0, pa1, pa2, pa3); partialSM(pA0, pA1, mnA, alA, (j + 1) * 64);
            __syncthreads(); SWRITE(1, 0);
            RESC(alA); __syncthreads();
        }
        SBAR(); qkt_c(pB0, pB1, K_lds + SHM_K);
        finishSM(pA0, pA1, alA, pa0, pa1, pa2, pa3); SBAR();
        pv_d0_s(o, vb0, pa0, pa1, pa2, pa3); partialSM(pB0, pB1, mnB, alB, (NT - 1) * 64);
        __syncthreads(); RESC(alB);
        finishSM(pB0, pB1, alB, pa0, pa1, pa2, pa3); SBAR();
        pv_d0_s(o, vb0 + SHM_V, pa0, pa1, pa2, pa3);
        __syncthreads();
    } else {
#if ATT_DMA
    DMA(0, 0); asm volatile("s_waitcnt vmcnt(0)" ::: "memory"); __syncthreads();
    if (wid >= 4) __builtin_amdgcn_s_setprio(1);
#pragma unroll 1
    for (int j = 0; j < NT; ++j) {
        const int cur = j & 1;
        if (j + 1 < NT) DMA(cur ^ 1, (j + 1) * 64);
        f32x16 p0, p1; float mn, alpha;
        qkt(p0, p1, cur * SHM_K);
        partialSM(p0, p1, mn, alpha, j * 64);
        finishSM(p0, p1, alpha, pa0, pa1, pa2, pa3);
        RESC(alpha);
        pv_d0(o, vb0 + cur * SHM_V, pa0, pa1, pa2, pa3);
        asm volatile("s_waitcnt vmcnt(0)" ::: "memory");
        __syncthreads();
    }
    __builtin_amdgcn_s_setprio(0);
#else
    SLOAD(0, 0); asm volatile("s_waitcnt vmcnt(0)" ::: "memory"); SWRITE(0, 0); __syncthreads();
    if (wid >= 4) __builtin_amdgcn_s_setprio(1);
#pragma unroll 1
    for (int j = 0; j < NT; ++j) {
        const int cur = j & 1;
        if (j + 1 < NT) SLOAD(0, (j + 1) * 64);
        f32x16 p0, p1; float mn, alpha;
        qkt(p0, p1, cur * SHM_K);
        partialSM(p0, p1, mn, alpha, j * 64);
        finishSM(p0, p1, alpha, pa0, pa1, pa2, pa3);
        RESC(alpha);
        pv_d0(o, vb0 + cur * SHM_V, pa0, pa1, pa2, pa3);
        if (j + 1 < NT) SWRITE(cur ^ 1, 0);
        __syncthreads();
    }
    __builtin_amdgcn_s_setprio(0);
#endif
    }
    if (hi == 0) li_l[r32] = l_reg; asm volatile("s_waitcnt lgkmcnt(0)" ::: "memory");
    char* ost = lds + wid * 8192;
#pragma unroll
    for (int r = 0; r < 16; ++r) { const int orow = crow(r, hi); const float rl = __builtin_amdgcn_rcpf(li_l[orow]);
#pragma unroll
        for (int d0 = 0; d0 < 4; ++d0) *(bf16_t*)(ost + orow * 256 + (d0 * 32 + r32) * 2) = f2bf(o[d0][r] * rl); }
    asm volatile("s_waitcnt lgkmcnt(0)" ::: "memory");
    {
        const int row = lane >> 1, hf = lane & 1;
        bf16_t* gp = a.O + (size_t)(wid * 32 + row) * a.ldo + hf * 64;
        const char* sp = ost + row * 256 + hf * 128;
        if (MODE != 1 || a.map == 0) {
#pragma unroll
            for (int c = 0; c < 8; ++c) *(u32x4*)(gp + c * 8) = *(const u32x4*)(sp + c * 16);
        } else {
            float v[64]; float ss = 0.f;
#pragma unroll
            for (int c = 0; c < 8; ++c) { const u32x4 w2 = *(const u32x4*)(sp + c * 16); const u32x4 w1 = *(const u32x4*)(gp + c * 8);
                v[c * 8 + 0] = bflo(w1.x) - a.lam * bflo(w2.x); v[c * 8 + 1] = bfhi(w1.x) - a.lam * bfhi(w2.x);
                v[c * 8 + 2] = bflo(w1.y) - a.lam * bflo(w2.y); v[c * 8 + 3] = bfhi(w1.y) - a.lam * bfhi(w2.y);
                v[c * 8 + 4] = bflo(w1.z) - a.lam * bflo(w2.z); v[c * 8 + 5] = bfhi(w1.z) - a.lam * bfhi(w2.z);
                v[c * 8 + 6] = bflo(w1.w) - a.lam * bflo(w2.w); v[c * 8 + 7] = bfhi(w1.w) - a.lam * bfhi(w2.w); }
#pragma unroll
            for (int i = 0; i < 64; ++i) ss += v[i] * v[i];
            ss += sx<1>(ss);
            const float rn = rsqrtf(ss * (1.f / 128.f) + EPS) * a.oscale;
            const float* gg = a.ga + hf * 64;
#pragma unroll
            for (int c = 0; c < 8; ++c) { const f32x4 g0 = *(const f32x4*)(gg + c * 8), g1 = *(const f32x4*)(gg + c * 8 + 4);
                u32x4 w; w.x = cvtpk(v[c * 8] * rn * g0[0], v[c * 8 + 1] * rn * g0[1]); w.y = cvtpk(v[c * 8 + 2] * rn * g0[2], v[c * 8 + 3] * rn * g0[3]);
                w.z = cvtpk(v[c * 8 + 4] * rn * g1[0], v[c * 8 + 5] * rn * g1[1]); w.w = cvtpk(v[c * 8 + 6] * rn * g1[2], v[c * 8 + 7] * rn * g1[3]);
                *(u32x4*)(gp + c * 8) = w; }
        }
    }
#undef SLOAD
#undef SWRITE
#undef SWAIT
#undef RESC
}
constexpr int ATT_AUX = 2 * 16384 + 2 * 64 * 384 + 8 * 64 * 4;
constexpr int ATT_TAB = ATT_AUX;
constexpr int ATT_IDX = ATT_AUX + 1040;

#ifndef A_DUAL
#define A_DUAL 0
#endif
#ifndef A_DUAL_VRING
#define A_DUAL_VRING 1
#endif
DI void attn_body_dual(const AttnArgs& a, char* lds) {
    constexpr int KROWB = 256, SHM_K = 64 * KROWB, SHM_V = 64 * 128 * 2, NI = 4, NB = 8;
    int tid = a.tid; asm volatile("" : "+v"(tid));
    const int wid = tid >> 6, lane = tid & 63, r32 = lane & 31, hi = lane >> 5;
    char* V_lds = lds; char* K_lds = lds + 2 * SHM_V;
    float* wsc = (float*)(lds + ATT_WSC) + wid * 64; float* li_l = wsc; float* al_l = wsc + 32;
    float m_reg, l_reg, mS0 = -1e30f, mS1 = -1e30f, lS0 = 0.f, lS1 = 0.f; f32x16 o1[4] = {}, o2[4] = {};
    char* qrl = lds + ATT_QR + wid * 8192 + lane * 16;
    const float C = a.C;
    auto ksw = [](int row) { return ((row & 7) | (((row >> 4) & 1) << 3)) << 4; };
    __syncthreads();
    const bf16_t* Qw = a.Q + (size_t)(wid * 32 + r32) * a.ldq + hi * 8;
#pragma unroll
    for (int d0 = 0; d0 < 8; ++d0) *(bf16x8*)(qrl + d0 * 1024) = *(const bf16x8*)(Qw + d0 * 16);
    const int qra = (int)(uintptr_t)qrl;
    const int vb0 = (int)(uintptr_t)V_lds + v_rd_base(lane);
    const bf16_t* sp[NI]; int sld[NI];
#pragma unroll
    for (int i = 0; i < NI; ++i) { const int b = wid + 8 * i;
        if (i < 2) { const int pos = b * 1024 + lane * 16, stl = pos >> 9, q = (pos & 511) >> 1, kk = (stl >> 2) * 8 + (q >> 5), c = (stl & 3) * 32 + (q & 31);
            const int k = (kk & ~0xC) | ((kk & 4) << 1) | ((kk & 8) >> 1);
            sp[i] = a.V + (size_t)k * a.ldv + c; sld[i] = a.ldv;
        } else { const int pos = (b - 16) * 1024 + lane * 16, row = pos / KROWB, within = pos - row * KROWB, c = (within ^ ksw(row)) >> 4;
            sp[i] = a.K + (size_t)row * a.ldk + c * 8; sld[i] = a.ldk; } }
    const int wu = __builtin_amdgcn_readfirstlane(wid);
#define DMA2(buf, k0) do { _Pragma("unroll") for (int _i = 0; _i < NI; ++_i) { \
        char* _d = (_i < 2) ? V_lds + (buf) * SHM_V + (wu + 8 * _i) * 1024 : K_lds + (buf) * SHM_K + (wu + 8 * _i - 16) * 1024; \
        __builtin_amdgcn_global_load_lds((const unsigned*)(sp[_i] + (size_t)(k0) * sld[_i]), (LAS unsigned*)_d, 16, 0, 0); } } while (0)
#define RESC2(O, al) do { if (__any((al) < 1.f)) { if (hi == 0) al_l[r32] = (al); asm volatile("s_waitcnt lgkmcnt(0)" ::: "memory"); \
    _Pragma("unroll") for (int d = 0; d < 4; ++d) _Pragma("unroll") for (int r = 0; r < 16; ++r) O[d][r] *= al_l[crow(r, hi)]; } } while (0)
    const int kX = (hi * 16) ^ ksw(r32), kbase = (int)(uintptr_t)K_lds + r32 * KROWB;
    auto qkt = [&](auto mc, f32x16& p0, f32x16& p1, const int kofs) {
        constexpr int M = decltype(mc)::value;
        p0 = f32x16{}; p1 = f32x16{};
        bf16x8 fk[2][2], fq[2];
        auto rd = [&](auto ic) { constexpr int d0 = decltype(ic)::value; constexpr int sl = d0 & 1;
            const int ka = kbase + kofs + (((4 * M + d0) * 32) ^ kX); dsr128<0>(fk[sl][0], ka); dsr128<32 * KROWB>(fk[sl][1], ka); dsr128<(4 * M + d0) * 1024>(fq[sl], qra); };
        rd(std::integral_constant<int, 0>{});
        cfor<0, 4>([&](auto ic) { constexpr int d0 = decltype(ic)::value; constexpr int sl = d0 & 1;
            if constexpr (d0 + 1 < 4) { rd(std::integral_constant<int, d0 + 1>{}); wait_lgkm<3>(); } else wait_lgkm<0>();
            SBAR();
            p0 = __builtin_amdgcn_mfma_f32_32x32x16_bf16(fk[sl][0], fq[sl], p0, 0, 0, 0);
            p1 = __builtin_amdgcn_mfma_f32_32x32x16_bf16(fk[sl][1], fq[sl], p1, 0, 0, 0); });
    };
    const int qw0 = a.qpos0 + wid * 32;
    auto softmax = [&](f32x16& p0, f32x16& p1, float& alpha, bf16x8* pa, const int k0) {
        float mn;
        const int relmax = k0 + 63 - qw0, relmin = k0 - qw0 - 31;
        if (relmax <= -128 || relmin >= 128) {
            const float bc = a.tab[relmax <= -128 ? 0 : 256];
            float pmax = p0[0];
#pragma unroll
            for (int r = 1; r < 16; ++r) pmax = fmaxf(pmax, p0[r]);
#pragma unroll
            for (int r = 0; r < 16; ++r) pmax = fmaxf(pmax, p1[r]);
            { auto rr = __builtin_amdgcn_permlane32_swap(__float_as_uint(pmax), __float_as_uint(pmax), false, false);
              pmax = fmaxf(__uint_as_float(rr[0]), __uint_as_float(rr[1])); }
            pmax = fmaf(pmax, C, bc);
            if (__builtin_expect(__all(pmax - m_reg <= THR_L2), 1)) { mn = m_reg; alpha = 1.f; }
            else { mn = fmaxf(m_reg, pmax); alpha = __builtin_amdgcn_exp2f(m_reg - mn); m_reg = mn; }
            const float off = bc - mn;
#pragma unroll
            for (int r = 0; r < 16; ++r) { p0[r] = fmaf(p0[r], C, off); p1[r] = fmaf(p1[r], C, off); }
        } else {
            const int base = k0 - (qw0 + r32) + 4 * hi + 128;
#pragma unroll
            for (int r = 0; r < 16; ++r) { const int i0 = base + (r & 3) + 8 * (r >> 2); p0[r] = fmaf(p0[r], C, a.tab[min(max(i0, 0), 256)]); }
            SBAR();
#pragma unroll
            for (int r = 0; r < 16; ++r) { const int i0 = base + 32 + (r & 3) + 8 * (r >> 2); p1[r] = fmaf(p1[r], C, a.tab[min(max(i0, 0), 256)]); }
            SBAR();
            float pmax = p0[0];
#pragma unroll
            for (int r = 1; r < 16; ++r) pmax = fmaxf(pmax, p0[r]);
#pragma unroll
            for (int r = 0; r < 16; ++r) pmax = fmaxf(pmax, p1[r]);
            { auto rr = __builtin_amdgcn_permlane32_swap(__float_as_uint(pmax), __float_as_uint(pmax), false, false);
              pmax = fmaxf(__uint_as_float(rr[0]), __uint_as_float(rr[1])); }
            if (__builtin_expect(__all(pmax - m_reg <= THR_L2), 1)) { mn = m_reg; alpha = 1.f; }
            else { mn = fmaxf(m_reg, pmax); alpha = __builtin_amdgcn_exp2f(m_reg - mn); m_reg = mn; }
#pragma unroll
            for (int r = 0; r < 16; ++r) { p0[r] -= mn; p1[r] -= mn; }
        }
#pragma unroll
        for (int r = 0; r < 16; ++r) { p0[r] = __builtin_amdgcn_exp2f(p0[r]); p1[r] = __builtin_amdgcn_exp2f(p1[r]); }
        float ps = 0;
#pragma unroll
        for (int r = 0; r < 16; ++r) ps += p0[r];
#pragma unroll
        for (int r = 0; r < 16; ++r) ps += p1[r];
        { auto rr = __builtin_amdgcn_permlane32_swap(__float_as_uint(ps), __float_as_uint(ps), false, false);
          ps = __uint_as_float(rr[0]) + __uint_as_float(rr[1]); }
        l_reg = l_reg * alpha + ps;
#define PK4(P, BASE, OUT) do { unsigned a0 = cvtpk(P[BASE + 0], P[BASE + 1]), a1 = cvtpk(P[BASE + 2], P[BASE + 3]);   \
    unsigned b0 = cvtpk(P[BASE + 4], P[BASE + 5]), b1 = cvtpk(P[BASE + 6], P[BASE + 7]);                              \
    auto r0 = __builtin_amdgcn_permlane32_swap(a0, b0, false, false); auto r1 = __builtin_amdgcn_permlane32_swap(a1, b1, false, false); \
    u32x4 w = {r0[0], r1[0], r0[1], r1[1]}; OUT = *reinterpret_cast<bf16x8*>(&w); } while (0)
        PK4(p0, 0, pa[0]); PK4(p0, 8, pa[1]); PK4(p1, 0, pa[2]); PK4(p1, 8, pa[3]);
#undef PK4
    };
    const int NT = a.seq / 64;
    DMA2(0, 0); asm volatile("s_waitcnt vmcnt(0)" ::: "memory"); __syncthreads();
    if (wid >= 4) __builtin_amdgcn_s_setprio(1);
#pragma unroll 1
    for (int j = 0; j < NT; ++j) {
        const int cur = j & 1;
        if (j + 1 < NT) DMA2(cur ^ 1, (j + 1) * 64);
        f32x16 p0, p1; float alpha; bf16x8 paA[4], paB[4];
        qkt(std::integral_constant<int, 0>{}, p0, p1, cur * SHM_K);
        m_reg = mS0; l_reg = lS0; softmax(p0, p1, alpha, paA, j * 64); mS0 = m_reg; lS0 = l_reg;
        RESC2(o1, alpha);
        qkt(std::integral_constant<int, 1>{}, p0, p1, cur * SHM_K);
        m_reg = mS1; l_reg = lS1; softmax(p0, p1, alpha, paB, j * 64); mS1 = m_reg; lS1 = l_reg;
        RESC2(o2, alpha);
        const int vb = vb0 + cur * SHM_V;
#if A_DUAL_VRING
        s16x4 fa[8], fb[8];
        v_rd8<0>(fa, vb);
        v_rd8<1>(fb, vb); wait_lgkm<8>(); SBAR(); pv_mm(o1, fa, paA[0]); pv_mm(o2, fa, paB[0]);
        v_rd8<2>(fa, vb); wait_lgkm<8>(); SBAR(); pv_mm(o1, fb, paA[1]); pv_mm(o2, fb, paB[1]);
        v_rd8<3>(fb, vb); wait_lgkm<8>(); SBAR(); pv_mm(o1, fa, paA[2]); pv_mm(o2, fa, paB[2]);
        wait_lgkm<0>(); SBAR(); pv_mm(o1, fb, paA[3]); pv_mm(o2, fb, paB[3]);
#else
        s16x4 fa[8];
        v_rd8<0>(fa, vb); wait_lgkm<0>(); SBAR(); pv_mm(o1, fa, paA[0]); pv_mm(o2, fa, paB[0]); SBAR();
        v_rd8<1>(fa, vb); wait_lgkm<0>(); SBAR(); pv_mm(o1, fa, paA[1]); pv_mm(o2, fa, paB[1]); SBAR();
        v_rd8<2>(fa, vb); wait_lgkm<0>(); SBAR(); pv_mm(o1, fa, paA[2]); pv_mm(o2, fa, paB[2]); SBAR();
        v_rd8<3>(fa, vb); wait_lgkm<0>(); SBAR(); pv_mm(o1, fa, paA[3]); pv_mm(o2, fa, paB[3]);
#endif
        asm volatile("s_waitcnt vmcnt(0)" ::: "memory");
        __syncthreads();
    }
    __builtin_amdgcn_s_setprio(0);
    if (hi == 0) { li_l[r32] = lS0; al_l[r32] = lS1; } asm volatile("s_waitcnt lgkmcnt(0)" ::: "memory");
    char* ost = lds + wid * 8192;
#pragma unroll
    for (int r = 0; r < 16; ++r) { const int orow = crow(r, hi); const float rl1 = __builtin_amdgcn_rcpf(li_l[orow]), rl2 = __builtin_amdgcn_rcpf(al_l[orow]) * a.lam;
#pragma unroll
        for (int d0 = 0; d0 < 4; ++d0) *(bf16_t*)(ost + orow * 256 + (d0 * 32 + r32) * 2) = f2bf(o1[d0][r] * rl1 - o2[d0][r] * rl2); }
    asm volatile("s_waitcnt lgkmcnt(0)" ::: "memory");
    { const int row = lane >> 1, hf = lane & 1;
      bf16_t* gp = a.O + (size_t)(wid * 32 + row) * a.ldo + hf * 64; const char* spp = ost + row * 256 + hf * 128;
      float v[64]; float ss = 0.f;
#pragma unroll
      for (int c = 0; c < 8; ++c) { const u32x4 w = *(const u32x4*)(spp + c * 16);
          v[c * 8 + 0] = bflo(w.x); v[c * 8 + 1] = bfhi(w.x); v[c * 8 + 2] = bflo(w.y); v[c * 8 + 3] = bfhi(w.y);
          v[c * 8 + 4] = bflo(w.z); v[c * 8 + 5] = bfhi(w.z); v[c * 8 + 6] = bflo(w.w); v[c * 8 + 7] = bfhi(w.w); }
#pragma unroll
      for (int i = 0; i < 64; ++i) ss += v[i] * v[i];
      ss += sx<1>(ss);
      const float rn = rsqrtf(ss * (1.f / 128.f) + EPS) * a.oscale; const float* gg = a.ga + hf * 64;
#pragma unroll
      for (int c = 0; c < 8; ++c) { const f32x4 g0 = *(const f32x4*)(gg + c * 8), g1 = *(const f32x4*)(gg + c * 8 + 4);
          u32x4 w; w.x = cvtpk(v[c * 8] * rn * g0[0], v[c * 8 + 1] * rn * g0[1]); w.y = cvtpk(v[c * 8 + 2] * rn * g0[2], v[c * 8 + 3] * rn * g0[3]);
          w.z = cvtpk(v[c * 8 + 4] * rn * g1[0], v[c * 8 + 5] * rn * g1[1]); w.w = cvtpk(v[c * 8 + 6] * rn * g1[2], v[c * 8 + 7] * rn * g1[3]);
          *(u32x4*)(gp + c * 8) = w; } }
#undef DMA2
#undef RESC2
}

DI void cvt_job(const float* __restrict__ src, int K, int N, int Npad, bf16_t* __restrict__ dst, int mode, float* tile, const int tid) {
    const int nkt = K / 64, ntile = nkt * (Npad / 256);
    const int r = tid >> 6, c = (tid & 63) * 4, u0 = c >> 6, cc = c & 63, wn = tid >> 3, kc = (tid & 7) * 8;
    for (int t = blockIdx.x; t < ntile; t += gridDim.x) {
        const int nt_ = t / nkt, kt = t - nt_ * nkt, k0 = kt * 64, n0 = nt_ * 256;
        f32x4 v[8];
#pragma unroll
        for (int i = 0; i < 8; ++i) { v[i] = (f32x4){0.f, 0.f, 0.f, 0.f};
            if (n0 + c < N) v[i] = *(const f32x4*)(src + (size_t)(k0 + r + 8 * i) * N + n0 + c); }
        __syncthreads();
#pragma unroll
        for (int i = 0; i < 8; ++i) { float* tp = tile + u0 * 4160 + (r + 8 * i) * 65 + cc; tp[0] = v[i][0]; tp[1] = v[i][1]; tp[2] = v[i][2]; tp[3] = v[i][3]; }
        __syncthreads();
#pragma unroll
        for (int u = 0; u < 4; ++u) {
            float x[8];
#pragma unroll
            for (int j = 0; j < 8; ++j) x[j] = tile[u * 4160 + (kc + j) * 65 + wn];
            const int n = n0 + u * 64 + wn; const int drow = mode == 0 ? n : ((n >> 7) * 256 + (mode == 2 ? 128 : 0) + (n & 127));
            u32x4 w; w.x = cvtpk(x[0], x[1]); w.y = cvtpk(x[2], x[3]); w.z = cvtpk(x[4], x[5]); w.w = cvtpk(x[6], x[7]);
            *(u32x4*)(dst + (size_t)drow * K + k0 + kc) = w;
        }
    }
}
DI void convert_jobs(const Params& P, int l, int jlo, int jhi, unsigned char* shm) {
    const int tid_ = fresh_tid(P);
    float* tile = (float*)shm; unsigned char* ws = P.ws();
#pragma nounroll
    for (int j = jlo; j < jhi; ++j) {
        int ii, K, N, Npad, mode = 0; size_t off;
        switch (j) {
        case 0: ii = 7; K = 2048; N = NIN; Npad = LDZ; off = W1_IN; break;
        case 1: ii = 17; K = 512; N = 1536; Npad = 1536; off = W1_CQ; break;
        case 2: ii = 18; K = 256; N = 2048; Npad = 2048; off = W1_CKV; break;
        case 3: ii = 19; K = 1024; N = 2048; Npad = 2048; off = W1_BR; break;
        case 4: ii = 20; K = 1024; N = 2048; Npad = 2048; off = W1_BR + (size_t)2048 * 1024 * 2; break;
        case 5: ii = 21; K = 1024; N = 2048; Npad = 2048; off = W1_BR + (size_t)2 * 2048 * 1024 * 2; break;
        case 6: ii = 22; K = 2048; N = 2048; Npad = 2048; off = W1_MIX; break;
        case 7: ii = 26; K = 2048; N = 512; Npad = 512; off = W1_XQ; break;
        case 8: ii = 27; K = 2048; N = 1024; Npad = 1024; off = W1_XKV; break;
        case 9: ii = 28; K = 512; N = 2048; Npad = 2048; off = W1_XOUT; break;
        case 10: ii = 31; K = 2048; N = DFF; Npad = DFF; off = W2_GU; mode = 1; break;
        case 11: ii = 32; K = 2048; N = DFF; Npad = DFF; off = W2_GU; mode = 2; break;
        default: ii = 33; K = DFF; N = 2048; Npad = 2048; off = W2_DN; break;
        }
        cvt_job(P.in(ii) + (size_t)l * K * N, K, N, Npad, (bf16_t*)(ws + off), mode, tile, tid_);
    }
}
DI void norm_rows(const Params& P, int nrows, int srcsel  , const float* g, bf16_t* dst) {
    const int tid_ = fresh_tid(P);
    const int wid = tid_ >> 6, lane = tid_ & 63;
    for (int t = blockIdx.x * 8 + wid; t < nrows; t += gridDim.x * 8) {
        const float* src = srcsel == 0 ? xin_row(P, t) : (t < 512 ? P.in(2) + (size_t)t * DM : P.in(3) + (size_t)(t - 512) * DM);
        f32x4 v[8]; float ss = 0.f;
#pragma unroll
        for (int j = 0; j < 8; ++j) { v[j] = *(const f32x4*)(src + j * 256 + lane * 4); ss += v[j][0] * v[j][0] + v[j][1] * v[j][1] + v[j][2] * v[j][2] + v[j][3] * v[j][3]; }
        ss = wave_sum(ss); const float rn = rsqrtf(ss * (1.f / 2048.f) + EPS);
#pragma unroll
        for (int j = 0; j < 8; ++j) { const f32x4 gg = *(const f32x4*)(g + j * 256 + lane * 4);
            u32x2 w; w.x = cvtpk(v[j][0] * rn * gg[0], v[j][1] * rn * gg[1]); w.y = cvtpk(v[j][2] * rn * gg[2], v[j][3] * rn * gg[3]);
            *(u32x2*)(dst + (size_t)t * DM + j * 256 + lane * 4) = w; }
    }
}
DI void norm_res(const Params& P, bool src_in, bool dst_out, const bf16_t* tmp, const float* gpost, const float* gpre, bf16_t* h) {
    const int tid_ = fresh_tid(P);
    const int wid = tid_ >> 6, lane = tid_ & 63;
    bf16_t* x16 = (bf16_t*)(P.ws() + WS_X16);
    for (int t = blockIdx.x * 8 + wid; t < T; t += gridDim.x * 8) {
        f32x4 y[8]; float ss = 0.f;
#pragma unroll
        for (int j = 0; j < 8; ++j) { const u32x2 w = *(const u32x2*)(tmp + (size_t)t * DM + j * 256 + lane * 4);
            y[j] = (f32x4){bflo(w.x), bfhi(w.x), bflo(w.y), bfhi(w.y)}; ss += y[j][0] * y[j][0] + y[j][1] * y[j][1] + y[j][2] * y[j][2] + y[j][3] * y[j][3]; }
        f32x4 xv[8];
        if (src_in) { const float* xs = xin_row(P, t);
#pragma unroll
            for (int j = 0; j < 8; ++j) xv[j] = *(const f32x4*)(xs + j * 256 + lane * 4);
        } else {
#pragma unroll
            for (int j = 0; j < 8; ++j) { const u32x2 w = *(const u32x2*)(x16 + (size_t)t * DM + j * 256 + lane * 4); xv[j] = (f32x4){bflo(w.x), bfhi(w.x), bflo(w.y), bfhi(w.y)}; } }
        ss = wave_sum(ss); const float rn = rsqrtf(ss * (1.f / 2048.f) + EPS);
        float s2 = 0.f;
#pragma unroll
        for (int j = 0; j < 8; ++j) { const f32x4 gg = *(const f32x4*)(gpost + j * 256 + lane * 4);
#pragma unroll
            for (int q = 0; q < 4; ++q) { y[j][q] = xv[j][q] + y[j][q] * rn * gg[q]; s2 += y[j][q] * y[j][q]; } }
        if (dst_out) { float* xd = P.out() + (size_t)t * DM;
#pragma unroll
            for (int j = 0; j < 8; ++j) *(f32x4*)(xd + j * 256 + lane * 4) = y[j];
        } else {
#pragma unroll
            for (int j = 0; j < 8; ++j) { u32x2 w; w.x = cvtpk(y[j][0], y[j][1]); w.y = cvtpk(y[j][2], y[j][3]); *(u32x2*)(x16 + (size_t)t * DM + j * 256 + lane * 4) = w; } }
        if (gpre) { s2 = wave_sum(s2); const float r2 = rsqrtf(s2 * (1.f / 2048.f) + EPS);
#pragma unroll
            for (int j = 0; j < 8; ++j) { const f32x4 gg = *(const f32x4*)(gpre + j * 256 + lane * 4);
                u32x2 w; w.x = cvtpk(y[j][0] * r2 * gg[0], y[j][1] * r2 * gg[1]); w.y = cvtpk(y[j][2] * r2 * gg[2], y[j][3] * r2 * gg[3]);
                *(u32x2*)(h + (size_t)t * DM + j * 256 + lane * 4) = w; } }
    }
}
DI void prep_phase(const Params& P, int l) {
    const int tid_ = fresh_tid(P);
    const int wid = tid_ >> 6, lane = tid_ & 63, half = lane >> 5, j = lane & 31;
    bf16_t* z = (bf16_t*)(P.ws() + WS_Z); const f32x2* rope = (const f32x2*)(P.ws() + WS_ROPE);
    const float* gbq = P.in(13) + l * 128; const float* gbk = P.in(14) + l * 128; const float* gcq = P.in(15) + l * 512; const float* gckv = P.in(16) + l * 256;
    float gq[4], gk[4], gcqv[8], gckvv[4];
#pragma unroll
    for (int i = 0; i < 4; ++i) { gq[i] = gbq[j + 32 * i]; gk[i] = gbk[j + 32 * i]; gckvv[i] = gckv[lane * 4 + i]; }
#pragma unroll
    for (int q = 0; q < 8; ++q) gcqv[q] = gcq[lane * 8 + q];
    constexpr int NTK = 2;
    const int stride = gridDim.x * 8;
    for (int t0 = blockIdx.x * 8 + wid; t0 < T; t0 += NTK * stride) {
        unsigned hv[NTK][5][4], kr1[NTK], kr2[NTK]; u32x4 wq[NTK]; u32x2 wkv[NTK]; f32x2 cr[NTK], cc[NTK], ct[NTK];
#pragma unroll
        for (int r = 0; r < NTK; ++r) { const int t = t0 + r * stride; const bf16_t* zr = z + (size_t)t * LDZ;
            const int s = t < 4096 ? t : (t < 8192 ? t - 4096 : t - 8192);
            cr[r] = rope[(s >> 6) * 32 + j]; cc[r] = rope[(s & 63) * 32 + j]; ct[r] = rope[s * 32 + j];
#pragma unroll
            for (int it = 0; it < 5; ++it) { const int hh = it * 2 + half; const int base = hh < 8 ? ZC_BQ + hh * 128 : ZC_BK + (hh - 8) * 128;
#pragma unroll
                for (int i = 0; i < 4; ++i) hv[r][it][i] = zr[base + j + 32 * i]; }
            wq[r] = *(const u32x4*)(zr + ZC_CQA + lane * 8); wkv[r] = *(const u32x2*)(zr + ZC_CKVA + lane * 4);
            kr1[r] = zr[ZC_CKR + j]; kr2[r] = zr[ZC_CKR + 32 + j]; }
#pragma unroll
        for (int r = 0; r < NTK; ++r) { const int t = t0 + r * stride; bf16_t* zr = z + (size_t)t * LDZ;
#pragma unroll
            for (int it = 0; it < 5; ++it) { const int hh = it * 2 + half; const int base = hh < 8 ? ZC_BQ + hh * 128 : ZC_BK + (hh - 8) * 128; const bool isq = hh < 8;
                float v0 = bf2f((unsigned short)hv[r][it][0]), v1 = bf2f((unsigned short)hv[r][it][1]), v2 = bf2f((unsigned short)hv[r][it][2]), v3 = bf2f((unsigned short)hv[r][it][3]);
                float ss = half_sum(v0 * v0 + v1 * v1 + v2 * v2 + v3 * v3); const float rn = rsqrtf(ss * (1.f / 128.f) + EPS);
                v0 *= rn * (isq ? gq[0] : gk[0]); v1 *= rn * (isq ? gq[1] : gk[1]); v2 *= rn * (isq ? gq[2] : gk[2]); v3 *= rn * (isq ? gq[3] : gk[3]);
                zr[base + j] = f2bf(v0 * cr[r].x - v1 * cr[r].y); zr[base + 32 + j] = f2bf(v0 * cr[r].y + v1 * cr[r].x);
                zr[base + 64 + j] = f2bf(v2 * cc[r].x - v3 * cc[r].y); zr[base + 96 + j] = f2bf(v2 * cc[r].y + v3 * cc[r].x); }
            { const u32x4 w = wq[r]; float x[8] = {bflo(w.x), bfhi(w.x), bflo(w.y), bfhi(w.y), bflo(w.z), bfhi(w.z), bflo(w.w), bfhi(w.w)};
              float ss = 0.f;
#pragma unroll
              for (int q = 0; q < 8; ++q) ss += x[q] * x[q];
              ss = wave_sum(ss); const float rn = rsqrtf(ss * (1.f / 512.f) + EPS);
#pragma unroll
              for (int q = 0; q < 8; ++q) x[q] *= rn * gcqv[q];
              u32x4 o; o.x = cvtpk(x[0], x[1]); o.y = cvtpk(x[2], x[3]); o.z = cvtpk(x[4], x[5]); o.w = cvtpk(x[6], x[7]); *(u32x4*)(zr + ZC_CQA + lane * 8) = o; }
            { const u32x2 w = wkv[r]; float x[4] = {bflo(w.x), bfhi(w.x), bflo(w.y), bfhi(w.y)};
              float ss = wave_sum(x[0] * x[0] + x[1] * x[1] + x[2] * x[2] + x[3] * x[3]); const float rn = rsqrtf(ss * (1.f / 256.f) + EPS);
#pragma unroll
              for (int q = 0; q < 4; ++q) x[q] *= rn * gckvv[q];
              u32x2 o; o.x = cvtpk(x[0], x[1]); o.y = cvtpk(x[2], x[3]); *(u32x2*)(zr + ZC_CKVA + lane * 4) = o; }
            if (half == 0) { const float x1 = bf2f((unsigned short)kr1[r]), x2 = bf2f((unsigned short)kr2[r]);
                zr[ZC_CKR + j] = f2bf(x1 * ct[r].x - x2 * ct[r].y); zr[ZC_CKR + 32 + j] = f2bf(x1 * ct[r].y + x2 * ct[r].x); }
        }
    }
}
DI int t5_bucket(int rel) {
    const int n = rel < 0 ? -rel : rel; int b;
    if (n < 8) b = n; else if (n < 12) b = 8; else if (n < 16) b = 9; else if (n < 23) b = 10; else if (n < 32) b = 11; else if (n < 46) b = 12; else if (n < 64) b = 13; else if (n < 91) b = 14; else b = 15;
    return (rel > 0 ? 16 : 0) + b;
}
DI void init_phase(const Params& P, unsigned char* shm) {
    const int tid_ = fresh_tid(P);
    unsigned char* ws = P.ws();
    if (blockIdx.x == 0) {
        int* ctl = (int*)(ws + WS_CTL);
        if (tid_ < 16) ctl[tid_] = 0;
        { unsigned* xbw = (unsigned*)(ws + WS_XB); for (int i = tid_; i < 3456; i += NTHR) xbw[i] = 0u; }
        if (tid_ >= 64 && tid_ < 128) { const int i = tid_ - 64;
            for (int l = 0; l < NLAYER; ++l) {
                const float s1 = wave_sum(P.in(8)[l * 64 + i] * P.in(9)[l * 64 + i]), s2 = wave_sum(P.in(10)[l * 64 + i] * P.in(11)[l * 64 + i]);
                const float lam_init = l == 0 ? 0.2f : 0.35550907f;
                if (i == 0) ((float*)(ctl + 16))[l] = __expf(s1) - __expf(s2) + lam_init; } }
    }
    f32x2* rope = (f32x2*)(ws + WS_ROPE);
    for (int idx = blockIdx.x * NTHR + tid_; idx < 8192 * 32; idx += gridDim.x * NTHR) {
        const int pos = idx >> 5, i = idx & 31;
        const float inv = __builtin_amdgcn_exp2f(-(float)i * 0.41524101186092029f);
        const float ang = (float)pos * inv;
        const float kk = rintf(ang * 0.15915494309189535f);
        float rr = fmaf(-kk, 6.28125f, ang); rr = fmaf(-kk, 0.0019353071795864769f, rr);
        const float rev = rr * 0.15915494309189535f;
        rope[idx] = (f32x2){__builtin_amdgcn_cosf(rev), __builtin_amdgcn_sinf(rev)};
    }
}

template <int TYPE>
DI void attn_phase(const Params& P, int l, unsigned char* shm, const int rep, const bool cross = false) {
    const int tid_ = fresh_tid(P);
    unsigned char* ws = P.ws(); int* ctl = (int*)(ws + WS_CTL);
    bf16_t* z = (bf16_t*)(ws + WS_Z); bf16_t* ckv = (bf16_t*)(ws + WS_H); bf16_t* cq = (bf16_t*)(ws + WS_CQ); bf16_t* o = (bf16_t*)(ws + WS_O);
    int* sidx = (int*)(shm + ATT_IDX); float* tab = (float*)(shm + ATT_TAB);
    for (;;) {
        __syncthreads();
        if (tid_ == 0) *sidx = atomicAdd(ctl + (l * 4 + (cross ? 3 : TYPE)) * 2 + rep, 1);
        __syncthreads();
        const int idx = *sidx;
        if (idx >= (cross ? 256 : 512)) break;
        const bool sample = idx < 256; const int w = idx & 255, head = w >> 5, qbl = w & 31;
        const int t0 = (sample ? 32 + qbl : qbl) * 256;
        const int seqstart = sample ? 8192 : (qbl < 16 ? 0 : 4096), seqlen = sample ? 8192 : 4096;
        AttnArgs a; a.tid = tid_; a.qpos0 = t0 - seqstart; a.seq = seqlen; a.tab = tab; a.rope = nullptr; a.K2 = nullptr; a.ldk2 = 0; a.map = 0; a.lam = 0.f; a.ga = nullptr; a.oscale = 1.f;
        if constexpr (TYPE == 0) {
            const float lam_init = l == 0 ? 0.2f : 0.35550907f;
            a.lam = ((const float*)(ctl + 16))[l]; a.ga = P.in(12) + l * 128; a.oscale = 1.f - lam_init;
            const float* rb = P.in(4);
            for (int i = tid_; i < 257; i += NTHR) tab[i] = rb[t5_bucket(i - 128) * 8 + head] * LOG2E;
            a.ldq = LDZ; a.ldk = LDZ; a.ldv = LDZ; a.ldo = 3072; a.C = 0.125f * LOG2E;
            a.V = z + (size_t)seqstart * LDZ + ZC_AV + head * 128; a.O = o + (size_t)t0 * 3072 + head * 128;
#if A_DUAL
            a.Q = z + (size_t)t0 * LDZ + ZC_AQ + head * 128; a.K = z + (size_t)seqstart * LDZ + ZC_AK + head * 128;
            attn_body_dual(a, (char*)shm);
#else
#pragma nounroll
            for (int mp = 0; mp < 2; ++mp) { a.map = mp;
                a.Q = z + (size_t)t0 * LDZ + ZC_AQ + head * 128 + mp * 64; a.K = z + (size_t)seqstart * LDZ + ZC_AK + head * 128 + mp * 64;
                attn_body<64, 1>(a, (char*)shm); }
#endif
        } else if constexpr (TYPE == 1) {
            a.rope = (const f32x2*)(ws + WS_ROPE);
            a.Q = cq + (size_t)t0 * 1536 + head * 192; a.ldq = 1536; a.K = ckv + (size_t)seqstart * 2048 + head * 256; a.ldk = 2048;
            a.K2 = z + (size_t)seqstart * LDZ + ZC_CKR; a.ldk2 = LDZ; a.V = ckv + (size_t)seqstart * 2048 + head * 256 + 128; a.ldv = 2048;
            a.O = o + (size_t)t0 * 3072 + 2048 + head * 128; a.ldo = 3072; a.C = 0.07216878364870322f * LOG2E;
            attn_body<192, 2>(a, (char*)shm);
        } else if (cross) {
            const bf16_t* xq = (const bf16_t*)(ws + WS_XQ); const bf16_t* mkv = (const bf16_t*)(ws + WS_MEMKV); bf16_t* xatt = (bf16_t*)(ws + WS_XATT);
            const int xh = idx >> 6, qb = idx & 63, xt0 = qb * 256, sq = qb < 16 ? 0 : (qb < 32 ? 1 : 2);
            a.qpos0 = 0; a.seq = 256;
            a.Q = xq + (size_t)xt0 * 512 + xh * 128; a.ldq = 512; a.K = mkv + (size_t)sq * 256 * 1024 + xh * 128; a.ldk = 1024;
            a.V = mkv + (size_t)sq * 256 * 1024 + 512 + xh * 128; a.ldv = 1024; a.O = xatt + (size_t)xt0 * 512 + xh * 128; a.ldo = 512; a.C = 0.08838834764831845f * LOG2E;
            attn_body<128, 0>(a, (char*)shm);
        } else {
            const int kvh = head >> 2;
            a.Q = z + (size_t)t0 * LDZ + ZC_BQ + head * 128; a.ldq = LDZ; a.K = z + (size_t)seqstart * LDZ + ZC_BK + kvh * 128; a.ldk = LDZ;
            a.V = z + (size_t)seqstart * LDZ + ZC_BV + kvh * 128; a.ldv = LDZ; a.O = o + (size_t)t0 * 3072 + 1024 + head * 128; a.ldo = 3072; a.C = 0.08838834764831845f * LOG2E;
            attn_body<128, 0>(a, (char*)shm);
        }
    }
}
#define XB_TMO      128
#define XB_XCNT(j)  (256  + 64 * (j))
#define XB_XSUB(j)  (1280 + 64 * (j))
#define XB_XGEN(j)  (2304 + 64 * (j))
#define XB_TOP      3328
#define XB_TOPGEN   3392
#define XCD_BAR_WORDS 3456
#define XB_SPIN_CAP (1u << 20)
DI unsigned xb_ld(unsigned* p)              { return __hip_atomic_load(p, __ATOMIC_RELAXED, __HIP_MEMORY_SCOPE_AGENT); }
DI unsigned xb_add(unsigned* p, unsigned v) { return __hip_atomic_fetch_add(p, v, __ATOMIC_RELAXED, __HIP_MEMORY_SCOPE_AGENT); }
DI unsigned xb_xcc_id() { return (unsigned)__builtin_amdgcn_s_getreg((3 << 11) | 20) & 0xFu; }
#define XB_SPIN(cond, bar) do { unsigned _sp = 0; while (cond) { __builtin_amdgcn_s_sleep(1); \
    if ((++_sp & 255u) == 0u) { if (xb_ld(&(bar)[XB_TMO])) break; if (_sp > XB_SPIN_CAP) { atomicAdd(&(bar)[XB_TMO], 1u); break; } } } } while (0)
DI void xcd_post(unsigned* bar) { if (threadIdx.x == 0) (void)xb_add(&bar[XB_XCNT(xb_xcc_id())], 1u); }
DI void xcd_complete(unsigned* bar, unsigned x, unsigned& nloc, unsigned& nx) {
    const unsigned G = gridDim.x;
    unsigned sum, cnt, mine, sp = 0u;
    for (;;) {
        sum = 0u; cnt = 0u; mine = 0u;
#pragma unroll
        for (unsigned j = 0; j < 16; ++j) { const unsigned c = xb_ld(&bar[XB_XCNT(j)]); sum += c; cnt += (c > 0u) ? 1u : 0u; mine = (j == x) ? c : mine; }
        if (sum == G) break;
        __builtin_amdgcn_s_sleep(1);
        if ((++sp & 255u) == 0u) { if (xb_ld(&bar[XB_TMO])) break; if (sp > XB_SPIN_CAP) { atomicAdd(&bar[XB_TMO], 1u); break; } }
    }
    nloc = mine > 0u ? mine : 1u; nx = cnt > 0u ? cnt : 1u;
}
DI void xcd_barrier(unsigned* bar, volatile LAS unsigned* st) {
    asm volatile("s_waitcnt vmcnt(0)" ::: "memory");
    __syncthreads();
    if (threadIdx.x == 0) {
        const unsigned x = xb_xcc_id();
        __builtin_amdgcn_s_waitcnt(0);
        unsigned nloc = st[0], nx = st[1];
        if (nloc == 0u) { xcd_complete(bar, x, nloc, nx); st[0] = nloc; st[1] = nx; }
        const unsigned old = xb_add(&bar[XB_XSUB(x)], 1u);
        const unsigned gen = old / nloc;
        if (old + 1u == (gen + 1u) * nloc) {
            __builtin_amdgcn_fence(__ATOMIC_RELEASE, "agent");
            asm volatile("s_waitcnt vmcnt(0)" ::: "memory");
            const unsigned og = xb_add(&bar[XB_TOP], 1u);
            const unsigned tg = og / nx;
            if (og + 1u == (tg + 1u) * nx) xb_add(&bar[XB_TOPGEN], 1u);
            else XB_SPIN(xb_ld(&bar[XB_TOPGEN]) == tg, bar);
            __builtin_amdgcn_fence(__ATOMIC_ACQUIRE, "agent");
            xb_add(&bar[XB_XGEN(x)], 1u);
            asm volatile("s_waitcnt vmcnt(0)" ::: "memory");
        } else {
            XB_SPIN(xb_ld(&bar[XB_XGEN(x)]) == gen, bar);
            __builtin_amdgcn_fence(__ATOMIC_ACQUIRE, "agent");
            asm volatile("s_waitcnt vmcnt(0)" ::: "memory");
        }
    }
    __syncthreads();
}

DI void gbar(unsigned* bar, unsigned target) {
    asm volatile("s_waitcnt vmcnt(0)" ::: "memory");
    __syncthreads();
    if (threadIdx.x == 0) {
        __builtin_amdgcn_fence(__ATOMIC_RELEASE, "agent");
        asm volatile("s_waitcnt vmcnt(0)" ::: "memory");
        __hip_atomic_fetch_add(bar, 1u, __ATOMIC_RELAXED, __HIP_MEMORY_SCOPE_AGENT);
        while (__hip_atomic_load(bar, __ATOMIC_RELAXED, __HIP_MEMORY_SCOPE_AGENT) < target) __builtin_amdgcn_s_sleep(1);
        __builtin_amdgcn_fence(__ATOMIC_ACQUIRE, "agent");
        asm volatile("s_waitcnt vmcnt(0)" ::: "memory");
    }
    __syncthreads();
}

constexpr int NPH = 1 + 16 * NLAYER;
DI void run_phase(const Params& P, int ph, unsigned char* shm, const int rep) {
    unsigned char* ws = P.ws();
    bf16_t* z = (bf16_t*)(ws + WS_Z); bf16_t* h = (bf16_t*)(ws + WS_H); bf16_t* tmp = (bf16_t*)(ws + WS_TMP);
    const int l = ph == 0 ? 0 : (ph - 1) / 16, s = ph == 0 ? -1 : (ph - 1) % 16;
    const bool more = l + 1 < NLAYER;
    if (s == -1) init_phase(P, shm);
    if (s == 8 || s == 12 || s == 15) {
        const int gi_post = s == 8 ? 6 : (s == 12 ? 24 : 30), gi_pre = s == 8 ? 23 : (s == 12 ? 29 : 5);
        const bool has_pre = s != 15 || more;
        norm_res(P, s == 8 && l == 0, s == 15 && !more, tmp, P.in(gi_post) + l * DM, has_pre ? P.in(gi_pre) + (s == 15 ? l + 1 : l) * DM : nullptr, h);
    }
    { int jlo = 0, jhi = 0, lw = l;
      if (s == -1) { jhi = 10; } else if (s == 8) { jlo = 10; jhi = 13; } else if (s == 15 && more) { jhi = 10; lw = l + 1; }
      if (jhi > jlo) convert_jobs(P, lw, jlo, jhi, shm); }
    if (s == -1) norm_rows(P, T, 0, P.in(5), h);
    if (s == -1 || (s == 15 && more)) norm_rows(P, 768, 1, P.in(25) + (s == -1 ? 0 : l + 1) * DM, (bf16_t*)(ws + WS_MEMN));
    if (s == 1) prep_phase(P, l);
    { const int ng = (s == 0 || s == 2) ? 2 : ((s == 6 || s == 7 || s == 9 || s == 11 || s == 13 || s == 14) ? 1 : 0);
#pragma nounroll
      for (int gi = 0; gi < ng; ++gi) {
          unsigned char* w = P.ws();
          bf16_t* zz = (bf16_t*)(w + WS_Z); bf16_t* hh = (bf16_t*)(w + WS_H); bf16_t* tt = (bf16_t*)(w + WS_TMP);
          GD d; gd_set(d, hh, DM, (const bf16_t*)(w + W1_MIX), T, DM, DM, tt, DM);
          switch (s * 2 + gi) {
          case 0: gd_set(d, hh, DM, (const bf16_t*)(w + W1_IN), T, LDZ, DM, zz, LDZ, 0, ZC_G); break;
          case 1: gd_set(d, (const bf16_t*)(w + WS_MEMN), DM, (const bf16_t*)(w + W1_XKV), 768, 1024, DM, (bf16_t*)(w + WS_MEMKV), 1024); d.coff = (int)gridDim.x / 2; break;
          case 4: gd_set(d, zz + ZC_CQA, LDZ, (const bf16_t*)(w + W1_CQ), T, 1536, 512, (bf16_t*)(w + WS_CQ), 1536); break;
          case 5: gd_set(d, zz + ZC_CKVA, LDZ, (const bf16_t*)(w + W1_CKV), T, 2048, 256, hh, 2048); break;
          case 12: gd_set(d, (const bf16_t*)(w + WS_O), 3072, (const bf16_t*)(w + W1_BR), T, DM, 1024, hh, DM, 2); d.nseg = 3; d.segA = 1024; d.segB = (long)2048 * 1024; d.Z = zz; break;
          case 18: gd_set(d, hh, DM, (const bf16_t*)(w + W1_XQ), T, 512, DM, (bf16_t*)(w + WS_XQ), 512); break;
          case 22: gd_set(d, (const bf16_t*)(w + WS_XATT), 512, (const bf16_t*)(w + W1_XOUT), T, DM, 512, tt, DM); break;
          case 26: gd_set(d, hh, DM, (const bf16_t*)(w + W2_GU), T, 2 * DFF, DM, (bf16_t*)(w + WS_U), DFF, 1); break;
          case 28: gd_set(d, (const bf16_t*)(w + WS_U), DFF, (const bf16_t*)(w + W2_DN), T, DM, DFF, tt, DM); break;
          default: break;
          }
          run_gemm(fresh_tid(P), shm, d); }
    }
    if (s == 3) attn_phase<0>(P, l, shm, rep);
    if (s == 3) attn_phase<1>(P, l, shm, rep);
    if (s == 3 || s == 10) attn_phase<2>(P, l, shm, rep, s == 10);
}

__global__ __launch_bounds__(NTHR, 2) void mega(KArgs A, int ph_lo, int ph_hi) {
    extern __shared__ __attribute__((aligned(16))) unsigned char shm[];
    cg::grid_group grid = cg::this_grid();
    { LAS unsigned long long* pt = (LAS unsigned long long*)(shm + PTAB_OFF);
#pragma unroll
      for (int i = 0; i < 34; ++i) if (threadIdx.x == i) pt[i] = (unsigned long long)A.in[i];
      if (threadIdx.x == 34) pt[34] = (unsigned long long)A.out;
      if (threadIdx.x == 35) pt[35] = (unsigned long long)A.ws;
      if (threadIdx.x == 36) { ((LAS unsigned*)(shm + PTAB_OFF + 384))[0] = 0u; ((LAS unsigned*)(shm + PTAB_OFF + 384))[1] = 0u; }
      __syncthreads(); }
    Params P; P.t = (LAS const unsigned long long*)(shm + PTAB_OFF);
    volatile LAS unsigned* xst = (volatile LAS unsigned*)(shm + PTAB_OFF + 384);
    const int wave_s = __builtin_amdgcn_readfirstlane((int)(threadIdx.x >> 6));
    int nbar = 0;
    for (int ph = ph_lo; ph < ph_hi; ++ph) {
        if (ph > 0 && (((ph - 1) % 16) == 4 || ((ph - 1) % 16) == 5)) continue;
        const int nrep = (REP_MASK != 0 && ph > 0 && ((REP_MASK >> ((ph - 1) % 16)) & 1)) ? 2 : 1;
        for (int rep = 0; rep < nrep; ++rep) {
            if (ph > ph_lo || rep > 0) { unsigned* xbw = (unsigned*)(P.ws() + WS_XB); if (nbar == 0) { grid.sync(); xcd_post(xbw); } else xcd_barrier(xbw, xst); ++nbar; }
            { int l_; asm volatile("v_mbcnt_lo_u32_b32 %0, -1, 0\n\tv_mbcnt_hi_u32_b32 %0, -1, %0" : "=v"(l_)); P.tid = wave_s * 64 + l_; }
            run_phase(P, ph, shm, rep);
        }
    }
}

extern "C" void kernel_launch(void* const* d_in, const int* in_sizes, int n_in, void* d_out, int out_size, void* d_ws, size_t ws_size, hipStream_t stream) {
    static int grid = 0;
    if (grid == 0) {
        if (n_in != 34 || out_size != T * DM || ws_size < WS_END) { fprintf(stderr, "kernel_launch: unexpected shapes n_in %d out %d ws %zu (need %zu)\n", n_in, out_size, ws_size, (size_t)WS_END); grid = -1; return; }
        if (hipFuncSetAttribute((const void*)mega, hipFuncAttributeMaxDynamicSharedMemorySize, LDS_BYTES) != hipSuccess) { fprintf(stderr, "kernel_launch: hipFuncSetAttribute failed\n"); grid = -1; return; }
        int dev = 0, cus = 0, per_cu = 0;
        hipGetDevice(&dev); hipDeviceGetAttribute(&cus, hipDeviceAttributeMultiprocessorCount, dev);
        hipOccupancyMaxActiveBlocksPerMultiprocessor(&per_cu, (const void*)mega, NTHR, LDS_BYTES);
        if (per_cu < 1) { fprintf(stderr, "kernel_launch: occupancy query says %d\n", per_cu); per_cu = 1; }
        (void)hipGetLastError();
        grid = cus;
    }
    if (grid < 0) return;
    KArgs p{};
    for (int i = 0; i < 34; ++i) p.in[i] = (const float*)d_in[i];
    p.out = (float*)d_out; p.ws = (unsigned char*)d_ws;
#if ONE_LAUNCH
    int lo = 0, hi = NPH; void* args[] = {&p, &lo, &hi};
    hipError_t e = hipLaunchCooperativeKernel((const void*)mega, dim3(grid), dim3(NTHR), args, LDS_BYTES, stream);
    if (e != hipSuccess) fprintf(stderr, "cooperative launch failed: %s (grid %d)\n", hipGetErrorString(e), grid);
#else
    for (int ph = 0; ph < NPH; ++ph) hipLaunchKernelGGL(mega, dim3(grid), dim3(NTHR), LDS_BYTES, stream, p, ph, ph + 1);
#endif
}
```

```cpp
#include <hip/hip_runtime.h>
#include <hip/hip_cooperative_groups.h>
#include <cstdio>
#include <cstdint>
#include <type_traits>
namespace cg = cooperative_groups;

#ifndef REP_MASK
#define REP_MASK 0
#endif
#ifndef ATT_DMA
#define ATT_DMA 1
#endif
#ifndef NQR_C
#define NQR_C 4
#endif
#ifndef PIPE2_MODES
#define PIPE2_MODES 0
#endif
#ifndef ONE_LAUNCH
#define ONE_LAUNCH 1
#endif

typedef unsigned short bf16_t;
typedef short bf16x8 __attribute__((ext_vector_type(8)));
typedef short s16x4 __attribute__((ext_vector_type(4)));
typedef float f32x2 __attribute__((ext_vector_type(2)));
typedef float f32x4 __attribute__((ext_vector_type(4)));
typedef float f32x16 __attribute__((ext_vector_type(16)));
typedef unsigned u32x2 __attribute__((ext_vector_type(2)));
typedef unsigned u32x4 __attribute__((ext_vector_type(4)));
#define LAS __attribute__((address_space(3)))
#define DI __device__ __forceinline__

constexpr int T = 16384, DM = 2048, LDZ = 11776, NIN = 11584, DFF = 5632, NLAYER = 2;
constexpr int ZC_AQ = 0, ZC_AK = 1024, ZC_AV = 2048, ZC_BQ = 3072, ZC_BK = 4096, ZC_BV = 4352, ZC_CQA = 4608, ZC_CKVA = 5120, ZC_CKR = 5376, ZC_G = 5440;
constexpr float EPS = 1e-6f, LOG2E = 1.4426950408889634f;
constexpr int NTHR = 512;
constexpr int LDS_BYTES = 152064 + 512;
constexpr int NOSIG = 0x7fffffff;

constexpr size_t W1_IN = 0;
constexpr size_t W1_CQ = W1_IN + (size_t)LDZ * 2048 * 2;
constexpr size_t W1_CKV = W1_CQ + (size_t)1536 * 512 * 2;
constexpr size_t W1_BR = W1_CKV + (size_t)2048 * 256 * 2;
constexpr size_t W1_MIX = W1_BR + (size_t)3 * 2048 * 1024 * 2;
constexpr size_t W1_XQ = W1_MIX + (size_t)2048 * 2048 * 2;
constexpr size_t W1_XKV = W1_XQ + (size_t)512 * 2048 * 2;
constexpr size_t W1_XOUT = W1_XKV + (size_t)1024 * 2048 * 2;
constexpr size_t W1_END = W1_XOUT + (size_t)2048 * 512 * 2;
constexpr size_t WS_Z = W1_END;
constexpr size_t WS_XQ = WS_Z, WS_XATT = WS_Z + (size_t)T * 512 * 2, WS_U = WS_Z;
constexpr size_t WS_H = WS_Z + (size_t)T * LDZ * 2;
constexpr size_t WS_O = WS_H + (size_t)T * 2048 * 2;
constexpr size_t WS_TMP = WS_O;
constexpr size_t W2_GU = WS_O + (size_t)T * 2048 * 2;
constexpr size_t W2_DN = W2_GU + (size_t)11264 * 2048 * 2;
constexpr size_t WS_CQ = WS_O + (size_t)T * 3072 * 2;
constexpr size_t WS_OEND = WS_CQ + (size_t)T * 1536 * 2;
static_assert(W2_DN + (size_t)2048 * 5632 * 2 <= WS_OEND, "W2 fits");
constexpr size_t WS_ROPE = WS_OEND;
constexpr size_t WS_MEMN = WS_ROPE + (size_t)8192 * 32 * 8;
constexpr size_t WS_MEMKV = WS_MEMN + (size_t)768 * 2048 * 2;
constexpr size_t WS_CTL = WS_MEMKV + (size_t)768 * 1024 * 2;
constexpr size_t WS_XB = WS_CTL + 256;
constexpr size_t WS_X16 = WS_XB + 16384;
constexpr size_t WS_END = WS_X16 + (size_t)T * 2048 * 2;
static_assert(WS_END <= (size_t)4 * 2 * 2048 * 11584 * 4, "workspace budget: 4 x the largest input (w_in)");

struct KArgs { const float* in[34]; float* out; unsigned char* ws; };
struct Params {
    LAS const unsigned long long* t; int tid;
    DI unsigned long long ld(int i) const { const unsigned long long v = t[i]; const unsigned lo = __builtin_amdgcn_readfirstlane((unsigned)v), hi = __builtin_amdgcn_readfirstlane((unsigned)(v >> 32)); return ((unsigned long long)hi << 32) | lo; }
    DI void* gp(int i) const { return (void*)(__attribute__((address_space(1))) void*)ld(i); }
    DI const float* in(int i) const { return (const float*)gp(i); }
    DI float* out() const { return (float*)gp(34); }
    DI unsigned char* ws() const { return (unsigned char*)gp(35); }
};
constexpr int PTAB_OFF = 152064;

DI unsigned cvtpk(float lo, float hi) { unsigned r; asm volatile("v_cvt_pk_bf16_f32 %0, %1, %2" : "=v"(r) : "v"(lo), "v"(hi)); return r; }
DI float bf2f(unsigned short b) { return __uint_as_float(((unsigned)b) << 16); }
DI float bflo(unsigned w) { return __uint_as_float(w << 16); }
DI float bfhi(unsigned w) { return __uint_as_float(w & 0xffff0000u); }
DI unsigned short f2bf(float f) { return (unsigned short)(cvtpk(f, f) & 0xffffu); }
template <int M> DI float sx(float v) { return __int_as_float(__builtin_amdgcn_ds_swizzle(__float_as_int(v), (M << 10) | 0x1f)); }
DI float half_sum(float v) { v += sx<16>(v); v += sx<8>(v); v += sx<4>(v); v += sx<2>(v); v += sx<1>(v); return v; }
DI float wave_sum(float v) { v = half_sum(v); auto rr = __builtin_amdgcn_permlane32_swap(__float_as_uint(v), __float_as_uint(v), false, false); return __uint_as_float(rr[0]) + __uint_as_float(rr[1]); }
DI float fsigmoid(float x) { return __builtin_amdgcn_rcpf(1.f + __expf(-x)); }
DI int fresh_tid(const Params& P) { int t = P.tid; asm volatile("" : "+v"(t)); return t; }
DI const float* xin_row(const Params& P, int t) { return t < 8192 ? P.in(0) + (size_t)t * DM : P.in(1) + (size_t)(t - 8192) * DM; }

namespace pg8 {
constexpr int BM = 256, BK = 64, HALF = 128, HTB = HALF * BK * 2, STAGE_BYTES = 8 * HTB, NXCD = 8, WGM = 8;
DI int lds_byte(int r, int c) { const int st = (r >> 4) * 2 + (c >> 5), rr = r & 15, cc = c & 31, ob = rr * 64 + cc * 2; return st * 1024 + (ob ^ (((ob >> 9) & 1) << 5)); }
DI void stage_rc(int b, int& R, int& C) { const int st = b / 1024, sb = b % 1024, swz = sb ^ (((sb >> 9) & 1) << 5); R = (st >> 1) * 16 + swz / 64; C = (st & 1) * 32 + (swz % 64) / 2; }
DI int perm32(int rho) { const int n = rho >> 4, i = rho & 15; return 8 * (i >> 2) + 4 * n + (i & 3); }

struct Unit { int pm, pn, seg; };
struct Gemm { const bf16_t* A; const bf16_t* Bt; int M, N, K, lda, nseg; long segA, segB; };

struct Order {
    int nM, nN, nwg, G, c, nseg;
    DI void init(int M, int N, int nseg_, int G_, int c_) { nM = M / BM; nN = N / BM; nwg = nM * nN; G = G_; c = c_; nseg = nseg_; }
    DI bool next(int i, Unit& u) const {
        const int rd = i / nseg; u.seg = i - rd * nseg;
        const long L = (long)rd * G + c; if (L >= nwg) return false;
        int wgid = (int)L; { const int q = nwg / NXCD, r = nwg % NXCD, xcd = wgid % NXCD, off = wgid / NXCD; wgid = (xcd < r ? xcd * (q + 1) : r * (q + 1) + (xcd - r) * q) + off; }
        const int nig = WGM * nN, gid = wgid / nig, fm = gid * WGM, gsz = (nM - fm) < WGM ? (nM - fm) : WGM;
        u.pm = fm + ((wgid % nig) % gsz); u.pn = (wgid % nig) / gsz; return true;
    }
};

template <class Epi>
DI void gemm_phase(LAS unsigned char* lds, const Gemm g, const Order& S, const Epi& E, const int tid) {
    const int wid = __builtin_amdgcn_readfirstlane(tid >> 6), lane = tid & 63, wr = wid >> 2, wc = wid & 3, fr = lane & 15, fq = lane >> 4;
    const int K = g.K, nt = K / BK;
    unsigned voffA[2], voffB[2];
#pragma unroll
    for (int i = 0; i < 2; ++i) { int R, C; stage_rc(tid * 16 + i * 8192, R, C); const int Rb = (R & ~31) + perm32(R & 31);
        voffA[i] = (unsigned)(R * g.lda + C) * 2u; voffB[i] = (unsigned)(Rb * K + C) * 2u; }
    const size_t kstep = (size_t)(BK * 2);
    const size_t hstepA = (size_t)HALF * g.lda * 2, hstepB = (size_t)HALF * K * 2;
    const size_t tstepA = 2 * hstepA, tstepB = 2 * hstepB;
    const unsigned ldsw = (unsigned)wid * 1024u;
    const int aoff = lds_byte(wr * 64 + fr, fq * 8), boff = lds_byte(wc * 32 + fr, fq * 8);
#define PG8_SA(b, h) (((b) * 2 + (h)) * HTB)
#define PG8_SB(b, h) ((4 + (b) * 2 + (h)) * HTB)
#define PG8_STAGE(bufoff, gbase, voff) do { _Pragma("unroll") for (int _i = 0; _i < 2; ++_i) \
        __builtin_amdgcn_global_load_lds((const unsigned*)((const char*)(gbase) + (voff)[_i]), (LAS unsigned*)(lds + (bufoff) + ldsw + _i * 8192), 16, 0, 0); } while (0)
#define PG8_LDA(dst, b, h) do { _Pragma("unroll") for (int m = 0; m < 4; ++m) _Pragma("unroll") for (int k = 0; k < 2; ++k) dst[m][k] = *(const LAS bf16x8*)(lds + PG8_SA(b, h) + aoff + m * 2048 + k * 1024); } while (0)
#define PG8_LDB(dst, b, h) do { _Pragma("unroll") for (int n = 0; n < 2; ++n) _Pragma("unroll") for (int k = 0; k < 2; ++k) dst[n][k] = *(const LAS bf16x8*)(lds + PG8_SB(b, h) + boff + n * 2048 + k * 1024); } while (0)
#define PG8_MMA(ai, bj, At, Bt) do { __builtin_amdgcn_s_setprio(1); _Pragma("unroll") for (int m = 0; m < 4; ++m) _Pragma("unroll") for (int n = 0; n < 2; ++n) _Pragma("unroll") for (int k = 0; k < 2; ++k) \
        acc[ai][bj][m][n] = __builtin_amdgcn_mfma_f32_16x16x32_bf16(Bt[n][k], At[m][k], acc[ai][bj][m][n], 0, 0, 0); __builtin_amdgcn_s_setprio(0); } while (0)
#define PG8_WAIT_V(n) asm volatile("s_waitcnt vmcnt(" #n ")" ::: "memory")
#define PG8_WAIT_L(n) asm volatile("s_waitcnt lgkmcnt(" #n ")" ::: "memory")
#define PG8_BAR __builtin_amdgcn_s_barrier()
#define PG8_SCHED __builtin_amdgcn_sched_barrier(0)
    Unit cur, nxt; int ui = 0;
    if (!S.next(0, cur)) return;
    f32x4 acc[2][2][4][2];
#pragma unroll
    for (int a = 0; a < 2; ++a)
#pragma unroll
        for (int b = 0; b < 2; ++b)
#pragma unroll
            for (int m = 0; m < 4; ++m)
#pragma unroll
                for (int n = 0; n < 2; ++n) acc[a][b][m][n] = (f32x4){0.f, 0.f, 0.f, 0.f};
    bf16x8 At[4][2], B0[2][2], B1[2][2];
    const char* cA = (const char*)(g.A + cur.seg * g.segA) + (size_t)cur.pm * tstepA; const char* cB = (const char*)(g.Bt + cur.seg * g.segB) + (size_t)cur.pn * tstepB;
    PG8_STAGE(PG8_SB(0, 0), cB, voffB); PG8_STAGE(PG8_SA(0, 0), cA, voffA); PG8_STAGE(PG8_SB(0, 1), cB + hstepB, voffB); PG8_STAGE(PG8_SA(0, 1), cA + hstepA, voffA);
    if (wr == 1) PG8_BAR;
    PG8_WAIT_V(4); PG8_BAR;
    PG8_STAGE(PG8_SB(1, 0), cB + kstep, voffB); PG8_STAGE(PG8_SA(1, 0), cA + kstep, voffA); PG8_STAGE(PG8_SB(1, 1), cB + hstepB + kstep, voffB);
    PG8_WAIT_V(6); PG8_BAR;
    for (;;) {
        const bool has_next = S.next(ui + 1, nxt);
        const char* nA = has_next ? (const char*)(g.A + nxt.seg * g.segA) + (size_t)nxt.pm * tstepA : cA;
        const char* nB = has_next ? (const char*)(g.Bt + nxt.seg * g.segB) + (size_t)nxt.pn * tstepB : cB;
        for (int t = 0; t < nt; t += 2) {
            const bool last = (t == nt - 2);
            const char* a1 = cA + (size_t)(t + 1) * kstep;
            const char* a2 = last ? nA : cA + (size_t)(t + 2) * kstep; const char* b2 = last ? nB : cB + (size_t)(t + 2) * kstep;
            const char* a3 = a2 + kstep; const char* b3 = b2 + kstep;
            PG8_LDB(B0, 0, 0); PG8_SCHED; PG8_LDA(At, 0, 0); PG8_STAGE(PG8_SA(1, 1), a1 + hstepA, voffA);
            PG8_WAIT_L(8); PG8_BAR; PG8_WAIT_L(0); PG8_MMA(0, 0, At, B0); PG8_BAR; PG8_SCHED;
            PG8_LDB(B1, 0, 1); PG8_STAGE(PG8_SB(0, 0), b2, voffB);
            PG8_BAR; PG8_WAIT_L(0); PG8_MMA(0, 1, At, B1); PG8_BAR;
            PG8_LDA(At, 0, 1); PG8_STAGE(PG8_SA(0, 0), a2, voffA);
            PG8_BAR; PG8_WAIT_L(0); PG8_MMA(1, 0, At, B0); PG8_BAR; PG8_SCHED;
            PG8_STAGE(PG8_SB(0, 1), b2 + hstepB, voffB);
            PG8_WAIT_V(6); PG8_BAR; PG8_MMA(1, 1, At, B1); PG8_BAR;
            PG8_LDB(B0, 1, 0); PG8_SCHED; PG8_LDA(At, 1, 0); PG8_STAGE(PG8_SA(0, 1), a2 + hstepA, voffA);
            PG8_WAIT_L(8); PG8_BAR; PG8_WAIT_L(0); PG8_MMA(0, 0, At, B0); PG8_BAR; PG8_SCHED;
            PG8_LDB(B1, 1, 1); PG8_STAGE(PG8_SB(1, 0), b3, voffB);
            PG8_BAR; PG8_WAIT_L(0); PG8_MMA(0, 1, At, B1); PG8_BAR;
            PG8_LDA(At, 1, 1); PG8_STAGE(PG8_SA(1, 0), a3, voffA);
            PG8_BAR; PG8_WAIT_L(0); PG8_MMA(1, 0, At, B0); PG8_BAR; PG8_SCHED;
            PG8_STAGE(PG8_SB(1, 1), b3 + hstepB, voffB);
            PG8_WAIT_V(6); PG8_BAR; PG8_MMA(1, 1, At, B1); PG8_BAR;
        }
        E(acc, cur, wr, wc, fr, fq);
        if (!has_next) break;
#pragma unroll
        for (int a = 0; a < 2; ++a)
#pragma unroll
            for (int b = 0; b < 2; ++b)
#pragma unroll
                for (int m = 0; m < 4; ++m)
#pragma unroll
                    for (int n = 0; n < 2; ++n) acc[a][b][m][n] = (f32x4){0.f, 0.f, 0.f, 0.f};
        cur = nxt; cA = nA; cB = nB; ++ui;
    }
    PG8_WAIT_V(0);
    if (wr == 0) PG8_BAR;
    PG8_BAR;
#undef PG8_SA
#undef PG8_SB
#undef PG8_STAGE
#undef PG8_LDA
#undef PG8_LDB
#undef PG8_MMA
#undef PG8_WAIT_V
#undef PG8_WAIT_L
#undef PG8_BAR
#undef PG8_SCHED
}

DI u32x4 pack8(f32x4 v0, f32x4 v1) { u32x4 w; w.x = cvtpk(v0[0], v0[1]); w.y = cvtpk(v0[2], v0[3]); w.z = cvtpk(v1[0], v1[1]); w.w = cvtpk(v1[2], v1[3]); return w; }
struct EpiAny {
    int mode; bf16_t* O; int ldc; int sigc; const bf16_t* Z;
    DI void operator()(const f32x4 (&acc)[2][2][4][2], const Unit& u, int wr, int wc, int fr, int fq) const {
        const int row0 = u.pm * BM + wr * 64 + fr;
        if (mode == 0) {
            const int col0 = u.pn * BM + wc * 32 + 8 * fq;
#pragma unroll
            for (int ai = 0; ai < 2; ++ai)
#pragma unroll
                for (int m = 0; m < 4; ++m) { bf16_t* rowp = O + (size_t)(row0 + ai * HALF + m * 16) * ldc + col0;
#pragma unroll
                    for (int bj = 0; bj < 2; ++bj) { f32x4 v0 = acc[ai][bj][m][0], v1 = acc[ai][bj][m][1];
                        if (col0 + bj * HALF >= sigc) {
#pragma unroll
                            for (int j = 0; j < 4; ++j) { v0[j] = fsigmoid(v0[j]); v1[j] = fsigmoid(v1[j]); } }
                        *(u32x4*)(rowp + bj * HALF) = pack8(v0, v1); } }
        } else if (mode == 1) {
            const int col0 = u.pn * HALF + wc * 32 + 8 * fq;
#pragma unroll
            for (int ai = 0; ai < 2; ++ai)
#pragma unroll
                for (int m = 0; m < 4; ++m) { bf16_t* rowp = O + (size_t)(row0 + ai * HALF + m * 16) * ldc + col0;
                    f32x4 v0, v1;
#pragma unroll
                    for (int j = 0; j < 4; ++j) { const float g0 = acc[ai][0][m][0][j], g1 = acc[ai][0][m][1][j];
                        v0[j] = g0 * fsigmoid(g0) * acc[ai][1][m][0][j]; v1[j] = g1 * fsigmoid(g1) * acc[ai][1][m][1][j]; }
                    *(u32x4*)rowp = pack8(v0, v1); }
        } else {
            const int col0 = u.pn * BM + wc * 32 + 8 * fq;
#pragma unroll
            for (int ai = 0; ai < 2; ++ai)
#pragma unroll
                for (int m = 0; m < 4; ++m) { const int row = row0 + ai * HALF + m * 16; bf16_t* rowp = O + (size_t)row * DM + col0;
                    const bf16_t* gp = Z + (size_t)row * LDZ + ZC_G + u.seg * DM + col0;
#pragma unroll
                    for (int bj = 0; bj < 2; ++bj) { const u32x4 gw = *(const u32x4*)(gp + bj * HALF);
                        f32x4 v0 = acc[ai][bj][m][0], v1 = acc[ai][bj][m][1];
                        v0[0] *= bflo(gw.x); v0[1] *= bfhi(gw.x); v0[2] *= bflo(gw.y); v0[3] *= bfhi(gw.y);
                        v1[0] *= bflo(gw.z); v1[1] *= bfhi(gw.z); v1[2] *= bflo(gw.w); v1[3] *= bfhi(gw.w);
                        if (u.seg > 0) { const u32x4 pw = *(const u32x4*)(rowp + bj * HALF);
                            v0[0] += bflo(pw.x); v0[1] += bfhi(pw.x); v0[2] += bflo(pw.y); v0[3] += bfhi(pw.y);
                            v1[0] += bflo(pw.z); v1[1] += bfhi(pw.z); v1[2] += bflo(pw.w); v1[3] += bfhi(pw.w); }
                        *(u32x4*)(rowp + bj * HALF) = pack8(v0, v1); } }
        }
    }
};
}

struct GD { const bf16_t* A; const bf16_t* Bt; bf16_t* O; const bf16_t* Z; int lda, M, N, K, ldc, sigc, mode, nseg, coff; long segA, segB; };
DI void gd_set(GD& d, const bf16_t* A, int lda, const bf16_t* Bt, int M, int N, int K, bf16_t* O, int ldc, int mode = 0, int sigc = NOSIG) {
    d.A = A; d.lda = lda; d.Bt = Bt; d.M = M; d.N = N; d.K = K; d.O = O; d.ldc = ldc; d.mode = mode; d.sigc = sigc; d.nseg = 1; d.segA = 0; d.segB = 0; d.Z = nullptr; d.coff = 0; }
DI void run_gemm(const int tid, unsigned char* shm, const GD& d) {
    pg8::Gemm g; g.A = d.A; g.Bt = d.Bt; g.M = d.M; g.N = d.N; g.K = d.K; g.lda = d.lda; g.nseg = d.nseg; g.segA = d.segA; g.segB = d.segB;
    pg8::EpiAny E; E.mode = d.mode; E.O = d.O; E.ldc = d.ldc; E.sigc = d.sigc; E.Z = d.Z;
    pg8::Order S; S.init(d.M, d.N, d.nseg, (int)gridDim.x, (int)((blockIdx.x + d.coff) % gridDim.x));
    pg8::gemm_phase<pg8::EpiAny>((LAS unsigned char*)shm, g, S, E, tid);
}

#define SBAR() __builtin_amdgcn_sched_barrier(0)
DI int crow(int r, int hi) { return (r & 3) + 8 * (r >> 2) + 4 * hi; }
DI int v_st(int k, int c) { const int kk = (k & ~0xC) | ((k & 4) << 1) | ((k & 8) >> 1); return ((kk >> 3) * 4 + (c >> 5)) * 512 + ((kk & 7) * 32 + (c & 31)) * 2; }
DI int v_rd_base(int lane) { return ((lane & 3) << 3) | (((lane >> 2) & 3) << 6) | (((lane >> 4) & 1) << 5) | (((lane >> 5) & 1) << 8); }
constexpr int v_rd_off(int d0, int ks, int half) { return d0 * 512 + ks * 4096 + half * 2048; }
template <int OFF> DI s16x4 tr_read(int vb) { s16x4 r; asm volatile("ds_read_b64_tr_b16 %0, %1 offset:%2" : "=&v"(r) : "v"(vb), "i"(OFF) : "memory"); return r; }
template <int I, int N, class F> DI void cfor(F&& f) { if constexpr (I < N) { f(std::integral_constant<int, I>{}); cfor<I + 1, N>(f); } }
template <int OFF> DI void dsr128(bf16x8& r, int addr) { asm volatile("ds_read_b128 %0, %1 offset:%2" : "=&v"(r) : "v"(addr), "i"(OFF) : "memory"); }
template <int N> DI void wait_lgkm() { asm volatile("s_waitcnt lgkmcnt(%0)" :: "i"(N) : "memory"); }
template <int KS> DI void v_rd8(s16x4* f, int vb) {
    f[0] = tr_read<v_rd_off(0, KS, 0)>(vb); f[1] = tr_read<v_rd_off(0, KS, 1)>(vb); f[2] = tr_read<v_rd_off(1, KS, 0)>(vb); f[3] = tr_read<v_rd_off(1, KS, 1)>(vb);
    f[4] = tr_read<v_rd_off(2, KS, 0)>(vb); f[5] = tr_read<v_rd_off(2, KS, 1)>(vb); f[6] = tr_read<v_rd_off(3, KS, 0)>(vb); f[7] = tr_read<v_rd_off(3, KS, 1)>(vb);
}
DI void pv_mm(f32x16* o, const s16x4* f, bf16x8 pa) {
#define PK(L, H) (bf16x8){L[0], L[1], L[2], L[3], H[0], H[1], H[2], H[3]}
    o[0] = __builtin_amdgcn_mfma_f32_32x32x16_bf16(pa, PK(f[0], f[1]), o[0], 0, 0, 0);
    o[1] = __builtin_amdgcn_mfma_f32_32x32x16_bf16(pa, PK(f[2], f[3]), o[1], 0, 0, 0);
    o[2] = __builtin_amdgcn_mfma_f32_32x32x16_bf16(pa, PK(f[4], f[5]), o[2], 0, 0, 0);
    o[3] = __builtin_amdgcn_mfma_f32_32x32x16_bf16(pa, PK(f[6], f[7]), o[3], 0, 0, 0);
#undef PK
}
DI void pv_d0(f32x16* o, int vb, bf16x8 pa0, bf16x8 pa1, bf16x8 pa2, bf16x8 pa3) {
    s16x4 fa[8], fb[8];
    v_rd8<0>(fa, vb);
    v_rd8<1>(fb, vb); wait_lgkm<8>(); SBAR(); pv_mm(o, fa, pa0);
    v_rd8<2>(fa, vb); wait_lgkm<8>(); SBAR(); pv_mm(o, fb, pa1);
    v_rd8<3>(fb, vb); wait_lgkm<8>(); SBAR(); pv_mm(o, fa, pa2);
    wait_lgkm<0>(); SBAR(); pv_mm(o, fb, pa3);
}

DI void pv_d0_s(f32x16* o, int vb, bf16x8 pa0, bf16x8 pa1, bf16x8 pa2, bf16x8 pa3) {
    s16x4 fa[8];
    v_rd8<0>(fa, vb); wait_lgkm<0>(); SBAR(); pv_mm(o, fa, pa0); SBAR();
    v_rd8<1>(fa, vb); wait_lgkm<0>(); SBAR(); pv_mm(o, fa, pa1); SBAR();
    v_rd8<2>(fa, vb); wait_lgkm<0>(); SBAR(); pv_mm(o, fa, pa2); SBAR();
    v_rd8<3>(fa, vb); wait_lgkm<0>(); SBAR(); pv_mm(o, fa, pa3);
}
struct AttnArgs {
    const bf16_t* Q; int ldq;
    const bf16_t* K; int ldk;
    const bf16_t* K2; int ldk2;
    const bf16_t* V; int ldv;
    bf16_t* O; int ldo;
    int seq; float C;
    int qpos0;
    const float* tab;
    const f32x2* rope;
    int map; float lam; const float* ga; float oscale;
    int tid;
};

constexpr float THR_L2 = 8.f * LOG2E;
constexpr int ATT_QR = 86016;
constexpr int ATT_WSC = 2 * 16384 + 2 * 64 * 384;

template <int DQK, int MODE>
DI void attn_body(const AttnArgs& a, char* lds) {
    constexpr int KROWB = DQK * 2, SHM_K = 64 * KROWB, SHM_V = 64 * 128 * 2, KCH = DQK / 64, CPR = DQK / 8, ND0 = DQK / 16, SD = 1;
    int tid = a.tid; asm volatile("" : "+v"(tid));
    const int wid = tid >> 6, lane = tid & 63, r32 = lane & 31, hi = lane >> 5;
    char* V_lds = lds; char* K_lds = lds + 2 * SHM_V;
    float* wsc = (float*)(lds + ATT_WSC) + wid * 64; float* li_l = wsc; float* al_l = wsc + 32;
    constexpr int NQR = (MODE == 2) ? NQR_C : ND0;
    float m_reg = -1e30f, l_reg = 0; f32x16 o[4] = {}; bf16x8 qr[NQR];
    char* qrl = lds + ATT_QR + wid * ((12 - NQR_C) * 1024) + lane * 16;
    const float C = a.C;
    auto ksw = [](int row) { return KROWB == 256 ? (((row & 7) | (((row >> 4) & 1) << 3)) << 4) : (((row >> 1) & 7) << 4); };
    __syncthreads();
    const bf16_t* Qw = a.Q + (size_t)(wid * 32 + r32) * a.ldq + hi * 8;
#pragma unroll
    for (int d0 = 0; d0 < NQR; ++d0) qr[d0] = *(const bf16x8*)(Qw + d0 * 16);
    if constexpr (MODE == 2) {
        const f32x2* rp = a.rope + (size_t)(a.qpos0 + wid * 32 + r32) * 32 + hi * 8;
#pragma unroll
        for (int dd = 0; dd < 2; ++dd) {
            bf16x8 x1 = *(const bf16x8*)(Qw + (8 + dd) * 16), x2 = *(const bf16x8*)(Qw + (10 + dd) * 16); bf16x8 y1, y2;
#pragma unroll
            for (int j = 0; j < 8; ++j) { const f32x2 cs = rp[dd * 16 + j]; const float a1 = bf2f((unsigned short)x1[j]), a2 = bf2f((unsigned short)x2[j]);
                y1[j] = (short)f2bf(a1 * cs.x - a2 * cs.y); y2[j] = (short)f2bf(a1 * cs.y + a2 * cs.x); }
            *(bf16x8*)(qrl + (8 + dd - NQR) * 1024) = y1; *(bf16x8*)(qrl + (10 + dd - NQR) * 1024) = y2; }
#pragma unroll
        for (int d0 = NQR; d0 < 8; ++d0) *(bf16x8*)(qrl + (d0 - NQR) * 1024) = *(const bf16x8*)(Qw + d0 * 16);
    }
    const int sr = tid >> 4, sc = (tid & 15) * 8, vst0 = v_st(sr, sc), vst1 = v_st(32 + sr, sc);
    const bf16_t* vp0 = a.V + (size_t)sr * a.ldv + sc; const bf16_t* vp1 = a.V + (size_t)(32 + sr) * a.ldv + sc;
    const bf16_t* kp[KCH]; int kld[KCH], kdst[KCH];
#pragma unroll
    for (int i = 0; i < KCH; ++i) { const int e = tid + i * NTHR, row = e / CPR, c = e % CPR;
        if (MODE == 2 && c >= 16) { kp[i] = a.K2 + (size_t)row * a.ldk2 + (c - 16) * 8; kld[i] = a.ldk2; }
        else { kp[i] = a.K + (size_t)row * a.ldk + c * 8; kld[i] = a.ldk; }
        kdst[i] = row * KROWB + ((c * 16) ^ ksw(row)); }
    const int vb0 = (int)(uintptr_t)V_lds + v_rd_base(lane);
    struct { bf16x8 vs0, vs1, ks[KCH]; } st_[SD];
#define SLOAD(i, k0) do { st_[i].vs0 = *(const bf16x8*)(vp0 + (size_t)(k0) * a.ldv); st_[i].vs1 = *(const bf16x8*)(vp1 + (size_t)(k0) * a.ldv); \
    _Pragma("unroll") for (int _q = 0; _q < KCH; ++_q) st_[i].ks[_q] = *(const bf16x8*)(kp[_q] + (size_t)(k0) * kld[_q]); } while (0)
#define SWRITE(b, i) do { *(bf16x8*)(V_lds + (b) * SHM_V + vst0) = st_[i].vs0; *(bf16x8*)(V_lds + (b) * SHM_V + vst1) = st_[i].vs1; \
    _Pragma("unroll") for (int _q = 0; _q < KCH; ++_q) *(bf16x8*)(K_lds + (b) * SHM_K + kdst[_q]) = st_[i].ks[_q]; } while (0)
#define SWAIT() do { if constexpr (SD == 2) { if constexpr (KCH == 1) asm volatile("s_waitcnt vmcnt(3)" ::: "memory"); else asm volatile("s_waitcnt vmcnt(4)" ::: "memory"); } \
    else asm volatile("s_waitcnt vmcnt(0)" ::: "memory"); } while (0)
#define RESC(al) do { if (__any((al) < 1.f)) { if (hi == 0) al_l[r32] = (al); asm volatile("s_waitcnt lgkmcnt(0)" ::: "memory"); \
    _Pragma("unroll") for (int d = 0; d < 4; ++d) _Pragma("unroll") for (int r = 0; r < 16; ++r) o[d][r] *= al_l[crow(r, hi)]; } } while (0)
#if ATT_DMA
    constexpr int NI = 2 + KCH;
    const bf16_t* sp[NI]; int sld[NI];
#pragma unroll
    for (int i = 0; i < NI; ++i) { const int b = wid + 8 * i;
        if (i < 2) { const int pos = b * 1024 + lane * 16, stl = pos >> 9, q = (pos & 511) >> 1, kk = (stl >> 2) * 8 + (q >> 5), c = (stl & 3) * 32 + (q & 31);
            const int k = (kk & ~0xC) | ((kk & 4) << 1) | ((kk & 8) >> 1);
            sp[i] = a.V + (size_t)k * a.ldv + c; sld[i] = a.ldv;
        } else { const int pos = (b - 16) * 1024 + lane * 16, row = pos / KROWB, within = pos - row * KROWB, c = (within ^ ksw(row)) >> 4;
            if (MODE == 2 && c >= 16) { sp[i] = a.K2 + (size_t)row * a.ldk2 + (c - 16) * 8; sld[i] = a.ldk2; }
            else { sp[i] = a.K + (size_t)row * a.ldk + c * 8; sld[i] = a.ldk; } } }
    const int wu = __builtin_amdgcn_readfirstlane(wid);
#define DMA(buf, k0) do { _Pragma("unroll") for (int _i = 0; _i < NI; ++_i) { \
        char* _d = (_i < 2) ? V_lds + (buf) * SHM_V + (wu + 8 * _i) * 1024 : K_lds + (buf) * SHM_K + (wu + 8 * _i - 16) * 1024; \
        __builtin_amdgcn_global_load_lds((const unsigned*)(sp[_i] + (size_t)(k0) * sld[_i]), (LAS unsigned*)_d, 16, 0, 0); } } while (0)
#endif
    constexpr int NB = (KROWB == 256) ? 8 : 4;
    int kb[NB];
    { const int X = (hi * 16) ^ ksw(r32);
#pragma unroll
      for (int i = 0; i < NB; ++i) kb[i] = (int)(uintptr_t)K_lds + r32 * KROWB + ((i * 32) ^ X); }
    const int qra = (int)(uintptr_t)qrl;
    auto qkt = [&](f32x16& p0, f32x16& p1, const int kofs) {
        p0 = f32x16{}; p1 = f32x16{};
        int kc[NB];
#pragma unroll
        for (int i = 0; i < NB; ++i) kc[i] = kb[i] + kofs;
        bf16x8 fk[2][2]; bf16x8 fq[2];
        auto rd = [&](auto ic) { constexpr int d0 = decltype(ic)::value; constexpr int sl = d0 & 1;
            dsr128<(d0 / NB) * (NB * 32)>(fk[sl][0], kc[d0 % NB]); dsr128<(d0 / NB) * (NB * 32) + 32 * KROWB>(fk[sl][1], kc[d0 % NB]);
            if constexpr (MODE == 2 && d0 >= NQR) dsr128<(d0 - NQR) * 1024>(fq[sl], qra); };
        rd(std::integral_constant<int, 0>{});
        cfor<0, ND0>([&](auto ic) { constexpr int d0 = decltype(ic)::value; constexpr int sl = d0 & 1;
            if constexpr (d0 + 1 < ND0) { rd(std::integral_constant<int, d0 + 1>{}); wait_lgkm<(MODE == 2 && d0 + 1 >= NQR) ? 3 : 2>(); }
            else wait_lgkm<0>();
            SBAR();
            bf16x8 qf; if constexpr (MODE == 2 && d0 >= NQR) qf = fq[sl]; else qf = qr[d0 < NQR ? d0 : 0];
            p0 = __builtin_amdgcn_mfma_f32_32x32x16_bf16(fk[sl][0], qf, p0, 0, 0, 0);
            p1 = __builtin_amdgcn_mfma_f32_32x32x16_bf16(fk[sl][1], qf, p1, 0, 0, 0); });
    };
    const int qw0 = a.qpos0 + wid * 32;
    auto partialSM = [&](f32x16& p0, f32x16& p1, float& mn, float& alpha, int k0) {
        if constexpr (MODE == 1) {
            const int relmax = k0 + 63 - qw0, relmin = k0 - qw0 - 31;
            if (relmax <= -128 || relmin >= 128) {
                const float bc = a.tab[relmax <= -128 ? 0 : 256];
                float pmax = p0[0];
#pragma unroll
                for (int r = 1; r < 16; ++r) pmax = fmaxf(pmax, p0[r]);
#pragma unroll
                for (int r = 0; r < 16; ++r) pmax = fmaxf(pmax, p1[r]);
                { auto rr = __builtin_amdgcn_permlane32_swap(__float_as_uint(pmax), __float_as_uint(pmax), false, false);
                  pmax = fmaxf(__uint_as_float(rr[0]), __uint_as_float(rr[1])); }
                pmax = fmaf(pmax, C, bc);
                if (__builtin_expect(__all(pmax - m_reg <= THR_L2), 1)) { mn = m_reg; alpha = 1.f; }
                else { mn = fmaxf(m_reg, pmax); alpha = __builtin_amdgcn_exp2f(m_reg - mn); m_reg = mn; }
                const float off = bc - mn;
#pragma unroll
                for (int r = 0; r < 16; ++r) { p0[r] = fmaf(p0[r], C, off); p1[r] = fmaf(p1[r], C, off); }
            } else {
                const int base = k0 - (qw0 + r32) + 4 * hi + 128;
#pragma unroll
                for (int r = 0; r < 16; ++r) { const int i0 = base + (r & 3) + 8 * (r >> 2);
                    const int j0 = min(max(i0, 0), 256), j1 = min(max(i0 + 32, 0), 256);
                    p0[r] = fmaf(p0[r], C, a.tab[j0]); p1[r] = fmaf(p1[r], C, a.tab[j1]); }
                float pmax = p0[0];
#pragma unroll
                for (int r = 1; r < 16; ++r) pmax = fmaxf(pmax, p0[r]);
#pragma unroll
                for (int r = 0; r < 16; ++r) pmax = fmaxf(pmax, p1[r]);
                { auto rr = __builtin_amdgcn_permlane32_swap(__float_as_uint(pmax), __float_as_uint(pmax), false, false);
                  pmax = fmaxf(__uint_as_float(rr[0]), __uint_as_float(rr[1])); }
                if (__builtin_expect(__all(pmax - m_reg <= THR_L2), 1)) { mn = m_reg; alpha = 1.f; }
                else { mn = fmaxf(m_reg, pmax); alpha = __builtin_amdgcn_exp2f(m_reg - mn); m_reg = mn; }
#pragma unroll
                for (int r = 0; r < 16; ++r) { p0[r] -= mn; p1[r] -= mn; }
            }
#pragma unroll
            for (int r = 0; r < 16; ++r) p0[r] = __builtin_amdgcn_exp2f(p0[r]);
        } else {
            float pmax = p0[0];
#pragma unroll
            for (int r = 1; r < 16; ++r) pmax = fmaxf(pmax, p0[r]);
#pragma unroll
            for (int r = 0; r < 16; ++r) pmax = fmaxf(pmax, p1[r]);
            { auto rr = __builtin_amdgcn_permlane32_swap(__float_as_uint(pmax), __float_as_uint(pmax), false, false);
              pmax = fmaxf(__uint_as_float(rr[0]), __uint_as_float(rr[1])); }
            if (__builtin_expect(__all((pmax - m_reg) * C <= THR_L2), 1)) { mn = m_reg; alpha = 1.f; }
            else { mn = fmaxf(m_reg, pmax); alpha = __builtin_amdgcn_exp2f((m_reg - mn) * C); m_reg = mn; }
            const float mnC = -mn * C;
#pragma unroll
            for (int r = 0; r < 16; ++r) { p0[r] = fmaf(p0[r], C, mnC); p1[r] = fmaf(p1[r], C, mnC); }
#pragma unroll
            for (int r = 0; r < 16; ++r) p0[r] = __builtin_amdgcn_exp2f(p0[r]);
        }
    };
    auto finishSM = [&](f32x16& p0, f32x16& p1, float alpha, bf16x8& pa0, bf16x8& pa1, bf16x8& pa2, bf16x8& pa3) {
#pragma unroll
        for (int r = 0; r < 16; ++r) p1[r] = __builtin_amdgcn_exp2f(p1[r]);
        float ps = 0;
#pragma unroll
        for (int r = 0; r < 16; ++r) ps += p0[r];
#pragma unroll
        for (int r = 0; r < 16; ++r) ps += p1[r];
        { auto rr = __builtin_amdgcn_permlane32_swap(__float_as_uint(ps), __float_as_uint(ps), false, false);
          ps = __uint_as_float(rr[0]) + __uint_as_float(rr[1]); }
        l_reg = l_reg * alpha + ps;
#define PK4(P, BASE, OUT) do { unsigned a0 = cvtpk(P[BASE + 0], P[BASE + 1]), a1 = cvtpk(P[BASE + 2], P[BASE + 3]);   \
    unsigned b0 = cvtpk(P[BASE + 4], P[BASE + 5]), b1 = cvtpk(P[BASE + 6], P[BASE + 7]);                              \
    auto r0 = __builtin_amdgcn_permlane32_swap(a0, b0, false, false); auto r1 = __builtin_amdgcn_permlane32_swap(a1, b1, false, false); \
    u32x4 w = {r0[0], r1[0], r0[1], r1[1]}; OUT = *reinterpret_cast<bf16x8*>(&w); } while (0)
        PK4(p0, 0, pa0); PK4(p0, 8, pa1); PK4(p1, 0, pa2); PK4(p1, 8, pa3);
#undef PK4
    };
    bf16x8 pa0, pa1, pa2, pa3; const int NT = a.seq / 64;
    if constexpr ((PIPE2_MODES >> MODE) & 1) {
        auto qkt_c = [&](f32x16& p0, f32x16& p1, const char* Ks) {
            p0 = f32x16{}; p1 = f32x16{};
#pragma unroll
            for (int d0 = 0; d0 < ND0; ++d0) { const int cb = (d0 * 16 + hi * 8) * 2;
                const bf16x8 b0 = *(const bf16x8*)(Ks + r32 * KROWB + (cb ^ ksw(r32)));
                const bf16x8 b1 = *(const bf16x8*)(Ks + (32 + r32) * KROWB + (cb ^ ksw(r32)));
                bf16x8 qf; if constexpr (MODE == 2) { if (d0 >= NQR) qf = *(const bf16x8*)(qrl + (d0 - NQR) * 1024); else qf = qr[d0 < NQR ? d0 : 0]; } else qf = qr[d0];
                p0 = __builtin_amdgcn_mfma_f32_32x32x16_bf16(b0, qf, p0, 0, 0, 0);
                p1 = __builtin_amdgcn_mfma_f32_32x32x16_bf16(b1, qf, p1, 0, 0, 0); }
        };
        f32x16 pA0, pA1, pB0, pB1; float mnA, mnB, alA, alB;
        SLOAD(0, 0); asm volatile("s_waitcnt vmcnt(0)" ::: "memory"); SWRITE(0, 0); __syncthreads();
        qkt_c(pA0, pA1, K_lds); partialSM(pA0, pA1, mnA, alA, 0);
        SLOAD(0, 64);
        SWRITE(1, 0); __syncthreads();
#pragma unroll 1
        for (int j = 1; j + 1 < NT; j += 2) {
            SBAR(); qkt_c(pB0, pB1, K_lds + SHM_K);
            finishSM(pA0, pA1, alA, pa0, pa1, pa2, pa3); SBAR();
            SLOAD(0, (j + 1) * 64); SBAR();
            pv_d0_s(o, vb0, pa0, pa1, pa2, pa3); partialSM(pB0, pB1, mnB, alB, j * 64);
            __syncthreads(); SWRITE(0, 0);
            RESC(alB); __syncthreads();
            SBAR(); qkt_c(pA0, pA1, K_lds);
            finishSM(pB0, pB1, alB, pa0, pa1, pa2, pa3); SBAR();
            SLOAD(0, (j + 2) * 64); SBAR();
            pv_d0_s(o, vb0 + SHM_V, pa0, pa1, pa2, pa3); partialSM(pA0, pA1, mnA, alA, (j + 1) * 64);
            __syncthreads(); SWRITE(1, 0);
            RESC(alA); __syncthreads();
        }
        SBAR(); qkt_c(pB0, pB1, K_lds + SHM_K);
        finishSM(pA0, pA1, alA, pa0, pa1, pa2, pa3); SBAR();
        pv_d0_s(o, vb0, pa0, pa1, pa2, pa3); partialSM(pB0, pB1, mnB, alB, (NT - 1) * 64);
        __syncthreads(); RESC(alB);
        finishSM(pB0, pB1, alB, pa0, pa1, pa2, pa3); SBAR();
        pv_d0_s(o, vb0 + SHM_V, pa0, pa1, pa2, pa3);
        __syncthreads();
    } else {
#if ATT_DMA
    DMA(0, 0); asm volatile("s_waitcnt vmcnt(0)" ::: "memory"); __syncthreads();
    if (wid >= 4) __builtin_amdgcn_s_setprio(1);
#pragma unroll 1
    for (int j = 0; j < NT; ++j) {
        const int cur = j & 1;
        if (j + 1 < NT) DMA(cur ^ 1, (j + 1) * 64);
        f32x16 p0, p1; float mn, alpha;
        qkt(p0, p1, cur * SHM_K);
        partialSM(p0, p1, mn, alpha, j * 64);
        finishSM(p0, p1, alpha, pa0, pa1, pa2, pa3);
        RESC(alpha);
        pv_d0(o, vb0 + cur * SHM_V, pa0, pa1, pa2, pa3);
        asm volatile("s_waitcnt vmcnt(0)" ::: "memory");
        __syncthreads();
    }
    __builtin_amdgcn_s_setprio(0);
#else
    SLOAD(0, 0); asm volatile("s_waitcnt vmcnt(0)" ::: "memory"); SWRITE(0, 0); __syncthreads();
    if (wid >= 4) __builtin_amdgcn_s_setprio(1);
#pragma unroll 1
    for (int j = 0; j < NT; ++j) {
        const int cur = j & 1;
        if (j + 1 < NT) SLOAD(0, (j + 1) * 64);
        f32x16 p0, p1; float mn, alpha;
        qkt(p0, p1, cur * SHM_K);
        partialSM(p0, p1, mn, alpha, j * 64);
        finishSM(p0, p1, alpha, pa0, pa1, pa2, pa3);
        RESC(alpha);
        pv_d0(o, vb0 + cur * SHM_V, pa0, pa1, pa2, pa3);
        if (j + 1 < NT) SWRITE(cur ^ 1, 0);
        __syncthreads();
    }
    __builtin_amdgcn_s_setprio(0);
#endif
    }
    if (hi == 0) li_l[r32] = l_reg; asm volatile("s_waitcnt lgkmcnt(0)" ::: "memory");
    char* ost = lds + wid * 8192;
#pragma unroll
    for (int r = 0; r < 16; ++r) { const int orow = crow(r, hi); const float rl = __builtin_amdgcn_rcpf(li_l[orow]);
#pragma unroll
        for (int d0 = 0; d0 < 4; ++d0) *(bf16_t*)(ost + orow * 256 + (d0 * 32 + r32) * 2) = f2bf(o[d0][r] * rl); }
    asm volatile("s_waitcnt lgkmcnt(0)" ::: "memory");
    {
        const int row = lane >> 1, hf = lane & 1;
        bf16_t* gp = a.O + (size_t)(wid * 32 + row) * a.ldo + hf * 64;
        const char* sp = ost + row * 256 + hf * 128;
        if (MODE != 1 || a.map == 0) {
#pragma unroll
            for (int c = 0; c < 8; ++c) *(u32x4*)(gp + c * 8) = *(const u32x4*)(sp + c * 16);
        } else {
            float v[64]; float ss = 0.f;
#pragma unroll
            for (int c = 0; c < 8; ++c) { const u32x4 w2 = *(const u32x4*)(sp + c * 16); const u32x4 w1 = *(const u32x4*)(gp + c * 8);
                v[c * 8 + 0] = bflo(w1.x) - a.lam * bflo(w2.x); v[c * 8 + 1] = bfhi(w1.x) - a.lam * bfhi(w2.x);
                v[c * 8 + 2] = bflo(w1.y) - a.lam * bflo(w2.y); v[c * 8 + 3] = bfhi(w1.y) - a.lam * bfhi(w2.y);
                v[c * 8 + 4] = bflo(w1.z) - a.lam * bflo(w2.z); v[c * 8 + 5] = bfhi(w1.z) - a.lam * bfhi(w2.z);
                v[c * 8 + 6] = bflo(w1.w) - a.lam * bflo(w2.w); v[c * 8 + 7] = bfhi(w1.w) - a.lam * bfhi(w2.w); }
#pragma unroll
            for (int i = 0; i < 64; ++i) ss += v[i] * v[i];
            ss += sx<1>(ss);
            const float rn = rsqrtf(ss * (1.f / 128.f) + EPS) * a.oscale;
            const float* gg = a.ga + hf * 64;
#pragma unroll
            for (int c = 0; c < 8; ++c) { const f32x4 g0 = *(const f32x4*)(gg + c * 8), g1 = *(const f32x4*)(gg + c * 8 + 4);
                u32x4 w; w.x = cvtpk(v[c * 8] * rn * g0[0], v[c * 8 + 1] * rn * g0[1]); w.y = cvtpk(v[c * 8 + 2] * rn * g0[2], v[c * 8 + 3] * rn * g0[3]);
                w.z = cvtpk(v[c * 8 + 4] * rn * g1[0], v[c * 8 + 5] * rn * g1[1]); w.w = cvtpk(v[c * 8 + 6] * rn * g1[2], v[c * 8 + 7] * rn * g1[3]);
                *(u32x4*)(gp + c * 8) = w; }
        }
    }
#undef SLOAD
#undef SWRITE
#undef SWAIT
#undef RESC
}
constexpr int ATT_AUX = 2 * 16384 + 2 * 64 * 384 + 8 * 64 * 4;
constexpr int ATT_TAB = ATT_AUX;
constexpr int ATT_IDX = ATT_AUX + 1040;

#ifndef A_DUAL
#define A_DUAL 0
#endif
#ifndef A_DUAL_VRING
#define A_DUAL_VRING 1
#endif
DI void attn_body_dual(const AttnArgs& a, char* lds) {
    constexpr int KROWB = 256, SHM_K = 64 * KROWB, SHM_V = 64 * 128 * 2, NI = 4, NB = 8;
    int tid = a.tid; asm volatile("" : "+v"(tid));
    const int wid = tid >> 6, lane = tid & 63, r32 = lane & 31, hi = lane >> 5;
    char* V_lds = lds; char* K_lds = lds + 2 * SHM_V;
    float* wsc = (float*)(lds + ATT_WSC) + wid * 64; float* li_l = wsc; float* al_l = wsc + 32;
    float m_reg, l_reg, mS0 = -1e30f, mS1 = -1e30f, lS0 = 0.f, lS1 = 0.f; f32x16 o1[4] = {}, o2[4] = {};
    char* qrl = lds + ATT_QR + wid * 8192 + lane * 16;
    const float C = a.C;
    auto ksw = [](int row) { return ((row & 7) | (((row >> 4) & 1) << 3)) << 4; };
    __syncthreads();
    const bf16_t* Qw = a.Q + (size_t)(wid * 32 + r32) * a.ldq + hi * 8;
#pragma unroll
    for (int d0 = 0; d0 < 8; ++d0) *(bf16x8*)(qrl + d0 * 1024) = *(const bf16x8*)(Qw + d0 * 16);
    const int qra = (int)(uintptr_t)qrl;
    const int vb0 = (int)(uintptr_t)V_lds + v_rd_base(lane);
    const bf16_t* sp[NI]; int sld[NI];
#pragma unroll
    for (int i = 0; i < NI; ++i) { const int b = wid + 8 * i;
        if (i < 2) { const int pos = b * 1024 + lane * 16, stl = pos >> 9, q = (pos & 511) >> 1, kk = (stl >> 2) * 8 + (q >> 5), c = (stl & 3) * 32 + (q & 31);
            const int k = (kk & ~0xC) | ((kk & 4) << 1) | ((kk & 8) >> 1);
            sp[i] = a.V + (size_t)k * a.ldv + c; sld[i] = a.ldv;
        } else { const int pos = (b - 16) * 1024 + lane * 16, row = pos / KROWB, within = pos - row * KROWB, c = (within ^ ksw(row)) >> 4;
            sp[i] = a.K + (size_t)row * a.ldk + c * 8; sld[i] = a.ldk; } }
    const int wu = __builtin_amdgcn_readfirstlane(wid);
#define DMA2(buf, k0) do { _Pragma("unroll") for (int _i = 0; _i < NI; ++_i) { \
        char* _d = (_i < 2) ? V_lds + (buf) * SHM_V + (wu + 8 * _i) * 1024 : K_lds + (buf) * SHM_K + (wu + 8 * _i - 16) * 1024; \
        __builtin_amdgcn_global_load_lds((const unsigned*)(sp[_i] + (size_t)(k0) * sld[_i]), (LAS unsigned*)_d, 16, 0, 0); } } while (0)
#define RESC2(O, al) do { if (__any((al) < 1.f)) { if (hi == 0) al_l[r32] = (al); asm volatile("s_waitcnt lgkmcnt(0)" ::: "memory"); \
    _Pragma("unroll") for (int d = 0; d < 4; ++d) _Pragma("unroll") for (int r = 0; r < 16; ++r) O[d][r] *= al_l[crow(r, hi)]; } } while (0)
    const int kX = (hi * 16) ^ ksw(r32), kbase = (int)(uintptr_t)K_lds + r32 * KROWB;
    auto qkt = [&](auto mc, f32x16& p0, f32x16& p1, const int kofs) {
        constexpr int M = decltype(mc)::value;
        p0 = f32x16{}; p1 = f32x16{};
        bf16x8 fk[2][2], fq[2];
        auto rd = [&](auto ic) { constexpr int d0 = decltype(ic)::value; constexpr int sl = d0 & 1;
            const int ka = kbase + kofs + (((4 * M + d0) * 32) ^ kX); dsr128<0>(fk[sl][0], ka); dsr128<32 * KROWB>(fk[sl][1], ka); dsr128<(4 * M + d0) * 1024>(fq[sl], qra); };
        rd(std::integral_constant<int, 0>{});
        cfor<0, 4>([&](auto ic) { constexpr int d0 = decltype(ic)::value; constexpr int sl = d0 & 1;
            if constexpr (d0 + 1 < 4) { rd(std::integral_constant<int, d0 + 1>{}); wait_lgkm<3>(); } else wait_lgkm<0>();
            SBAR();
            p0 = __builtin_amdgcn_mfma_f32_32x32x16_bf16(fk[sl][0], fq[sl], p0, 0, 0, 0);
            p1 = __builtin_amdgcn_mfma_f32_32x32x16_bf16(fk[sl][1], fq[sl], p1, 0, 0, 0); });
    };
    const int qw0 = a.qpos0 + wid * 32;
    auto softmax = [&](f32x16& p0, f32x16& p1, float& alpha, bf16x8* pa, const int k0) {
        float mn;
        const int relmax = k0 + 63 - qw0, relmin = k0 - qw0 - 31;
        if (relmax <= -128 || relmin >= 128) {
            const float bc = a.tab[relmax <= -128 ? 0 : 256];
            float pmax = p0[0];
#pragma unroll
            for (int r = 1; r < 16; ++r) pmax = fmaxf(pmax, p0[r]);
#pragma unroll
            for (int r = 0; r < 16; ++r) pmax = fmaxf(pmax, p1[r]);
            { auto rr = __builtin_amdgcn_permlane32_swap(__float_as_uint(pmax), __float_as_uint(pmax), false, false);
              pmax = fmaxf(__uint_as_float(rr[0]), __uint_as_float(rr[1])); }
            pmax = fmaf(pmax, C, bc);
            if (__builtin_expect(__all(pmax - m_reg <= THR_L2), 1)) { mn = m_reg; alpha = 1.f; }
            else { mn = fmaxf(m_reg, pmax); alpha = __builtin_amdgcn_exp2f(m_reg - mn); m_reg = mn; }
            const float off = bc - mn;
#pragma unroll
            for (int r = 0; r < 16; ++r) { p0[r] = fmaf(p0[r], C, off); p1[r] = fmaf(p1[r], C, off); }
        } else {
            const int base = k0 - (qw0 + r32) + 4 * hi + 128;
#pragma unroll
            for (int r = 0; r < 16; ++r) { const int i0 = base + (r & 3) + 8 * (r >> 2); p0[r] = fmaf(p0[r], C, a.tab[min(max(i0, 0), 256)]); }
            SBAR();
#pragma unroll
            for (int r = 0; r < 16; ++r) { const int i0 = base + 32 + (r & 3) + 8 * (r >> 2); p1[r] = fmaf(p1[r], C, a.tab[min(max(i0, 0), 256)]); }
            SBAR();
            float pmax = p0[0];
#pragma unroll
            for (int r = 1; r < 16; ++r) pmax = fmaxf(pmax, p0[r]);
#pragma unroll
            for (int r = 0; r < 16; ++r) pmax = fmaxf(pmax, p1[r]);
            { auto rr = __builtin_amdgcn_permlane32_swap(__float_as_uint(pmax), __float_as_uint(pmax), false, false);
              pmax = fmaxf(__uint_as_float(rr[0]), __uint_as_float(rr[1])); }
            if (__builtin_expect(__all(pmax - m_reg <= THR_L2), 1)) { mn = m_reg; alpha = 1.f; }
            else { mn = fmaxf(m_reg, pmax); alpha = __builtin_amdgcn_exp2f(m_reg - mn); m_reg = mn; }
#pragma unroll
            for (int r = 0; r < 16; ++r) { p0[r] -= mn; p1[r] -= mn; }
        }
#pragma unroll
        for (int r = 0; r < 16; ++r) { p0[r] = __builtin_amdgcn_exp2f(p0[r]); p1[r] = __builtin_amdgcn_exp2f(p1[r]); }
        float ps = 0;
#pragma unroll
        for (int r = 0; r < 16; ++r) ps += p0[r];
#pragma unroll
        for (int r = 0; r < 16; ++r) ps += p1[r];
        { auto rr = __builtin_amdgcn_permlane32_swap(__float_as_uint(ps), __float_as_uint(ps), false, false);
          ps = __uint_as_float(rr[0]) + __uint_as_float(rr[1]); }
        l_reg = l_reg * alpha + ps;
#define PK4(P, BASE, OUT) do { unsigned a0 = cvtpk(P[BASE + 0], P[BASE + 1]), a1 = cvtpk(P[BASE + 2], P[BASE + 3]);   \
    unsigned b0 = cvtpk(P[BASE + 4], P[BASE + 5]), b1 = cvtpk(P[BASE + 6], P[BASE + 7]);                              \
    auto r0 = __builtin_amdgcn_permlane32_swap(a0, b0, false, false); auto r1 = __builtin_amdgcn_permlane32_swap(a1, b1, false, false); \
    u32x4 w = {r0[0], r1[0], r0[1], r1[1]}; OUT = *reinterpret_cast<bf16x8*>(&w); } while (0)
        PK4(p0, 0, pa[0]); PK4(p0, 8, pa[1]); PK4(p1, 0, pa[2]); PK4(p1, 8, pa[3]);
#undef PK4
    };
    const int NT = a.seq / 64;
    DMA2(0, 0); asm volatile("s_waitcnt vmcnt(0)" ::: "memory"); __syncthreads();
    if (wid >= 4) __builtin_amdgcn_s_setprio(1);
#pragma unroll 1
    for (int j = 0; j < NT; ++j) {
        const int cur = j & 1;
        if (j + 1 < NT) DMA2(cur ^ 1, (j + 1) * 64);
        f32x16 p0, p1; float alpha; bf16x8 paA[4], paB[4];
        qkt(std::integral_constant<int, 0>{}, p0, p1, cur * SHM_K);
        m_reg = mS0; l_reg = lS0; softmax(p0, p1, alpha, paA, j * 64); mS0 = m_reg; lS0 = l_reg;
        RESC2(o1, alpha);
        qkt(std::integral_constant<int, 1>{}, p0, p1, cur * SHM_K);
        m_reg = mS1; l_reg = lS1; softmax(p0, p1, alpha, paB, j * 64); mS1 = m_reg; lS1 = l_reg;
        RESC2(o2, alpha);
        const int vb = vb0 + cur * SHM_V;
#if A_DUAL_VRING
        s16x4 fa[8], fb[8];
        v_rd8<0>(fa, vb);
        v_rd8<1>(fb, vb); wait_lgkm<8>(); SBAR(); pv_mm(o1, fa, paA[0]); pv_mm(o2, fa, paB[0]);
        v_rd8<2>(fa, vb); wait_lgkm<8>(); SBAR(); pv_mm(o1, fb, paA[1]); pv_mm(o2, fb, paB[1]);
        v_rd8<3>(fb, vb); wait_lgkm<8>(); SBAR(); pv_mm(o1, fa, paA[2]); pv_mm(o2, fa, paB[2]);
        wait_lgkm<0>(); SBAR(); pv_mm(o1, fb, paA[3]); pv_mm(o2, fb, paB[3]);
#else
        s16x4 fa[8];
        v_rd8<0>(fa, vb); wait_lgkm<0>(); SBAR(); pv_mm(o1, fa, paA[0]); pv_mm(o2, fa, paB[0]); SBAR();
        v_rd8<1>(fa, vb); wait_lgkm<0>(); SBAR(); pv_mm(o1, fa, paA[1]); pv_mm(o2, fa, paB[1]); SBAR();
        v_rd8<2>(fa, vb); wait_lgkm<0>(); SBAR(); pv_mm(o1, fa, paA[2]); pv_mm(o2, fa, paB[2]); SBAR();
        v_rd8<3>(fa, vb); wait_lgkm<0>(); SBAR(); pv_mm(o1, fa, paA[3]); pv_mm(o2, fa, paB[3]);
#endif
        asm volatile("s_waitcnt vmcnt(0)" ::: "memory");
        __syncthreads();
    }
    __builtin_amdgcn_s_setprio(0);
    if (hi == 0) { li_l[r32] = lS0; al_l[r32] = lS1; } asm volatile("s_waitcnt lgkmcnt(0)" ::: "memory");
    char* ost = lds + wid * 8192;
#pragma unroll
    for (int r = 0; r < 16; ++r) { const int orow = crow(r, hi); const float rl1 = __builtin_amdgcn_rcpf(li_l[orow]), rl2 = __builtin_amdgcn_rcpf(al_l[orow]) * a.lam;
#pragma unroll
        for (int d0 = 0; d0 < 4; ++d0) *(bf16_t*)(ost + orow * 256 + (d0 * 32 + r32) * 2) = f2bf(o1[d0][r] * rl1 - o2[d0][r] * rl2); }
    asm volatile("s_waitcnt lgkmcnt(0)" ::: "memory");
    { const int row = lane >> 1, hf = lane & 1;
      bf16_t* gp = a.O + (size_t)(wid * 32 + row) * a.ldo + hf * 64; const char* spp = ost + row * 256 + hf * 128;
      float v[64]; float ss = 0.f;
#pragma unroll
      for (int c = 0; c < 8; ++c) { const u32x4 w = *(const u32x4*)(spp + c * 16);
          v[c * 8 + 0] = bflo(w.x); v[c * 8 + 1] = bfhi(w.x); v[c * 8 + 2] = bflo(w.y); v[c * 8 + 3] = bfhi(w.y);
          v[c * 8 + 4] = bflo(w.z); v[c * 8 + 5] = bfhi(w.z); v[c * 8 + 6] = bflo(w.w); v[c * 8 + 7] = bfhi(w.w); }
#pragma unroll
      for (int i = 0; i < 64; ++i) ss += v[i] * v[i];
      ss += sx<1>(ss);
      const float rn = rsqrtf(ss * (1.f / 128.f) + EPS) * a.oscale; const float* gg = a.ga + hf * 64;
#pragma unroll
      for (int c = 0; c < 8; ++c) { const f32x4 g0 = *(const f32x4*)(gg + c * 8), g1 = *(const f32x4*)(gg + c * 8 + 4);
          u32x4 w; w.x = cvtpk(v[c * 8] * rn * g0[0], v[c * 8 + 1] * rn * g0[1]); w.y = cvtpk(v[c * 8 + 2] * rn * g0[2], v[c * 8 + 3] * rn * g0[3]);
          w.z = cvtpk(v[c * 8 + 4] * rn * g1[0], v[c * 8 + 5] * rn * g1[1]); w.w = cvtpk(v[c * 8 + 6] * rn * g1[2], v[c * 8 + 7] * rn * g1[3]);
          *(u32x4*)(gp + c * 8) = w; } }
#undef DMA2
#undef RESC2
}

DI void cvt_job(const float* __restrict__ src, int K, int N, int Npad, bf16_t* __restrict__ dst, int mode, float* tile, const int tid) {
    const int nkt = K / 64, ntile = nkt * (Npad / 256);
    const int r = tid >> 6, c = (tid & 63) * 4, u0 = c >> 6, cc = c & 63, wn = tid >> 3, kc = (tid & 7) * 8;
    for (int t = blockIdx.x; t < ntile; t += gridDim.x) {
        const int nt_ = t / nkt, kt = t - nt_ * nkt, k0 = kt * 64, n0 = nt_ * 256;
        f32x4 v[8];
#pragma unroll
        for (int i = 0; i < 8; ++i) { v[i] = (f32x4){0.f, 0.f, 0.f, 0.f};
            if (n0 + c < N) v[i] = *(const f32x4*)(src + (size_t)(k0 + r + 8 * i) * N + n0 + c); }
        __syncthreads();
#pragma unroll
        for (int i = 0; i < 8; ++i) { float* tp = tile + u0 * 4160 + (r + 8 * i) * 65 + cc; tp[0] = v[i][0]; tp[1] = v[i][1]; tp[2] = v[i][2]; tp[3] = v[i][3]; }
        __syncthreads();
#pragma unroll
        for (int u = 0; u < 4; ++u) {
            float x[8];
#pragma unroll
            for (int j = 0; j < 8; ++j) x[j] = tile[u * 4160 + (kc + j) * 65 + wn];
            const int n = n0 + u * 64 + wn; const int drow = mode == 0 ? n : ((n >> 7) * 256 + (mode == 2 ? 128 : 0) + (n & 127));
            u32x4 w; w.x = cvtpk(x[0], x[1]); w.y = cvtpk(x[2], x[3]); w.z = cvtpk(x[4], x[5]); w.w = cvtpk(x[6], x[7]);
            *(u32x4*)(dst + (size_t)drow * K + k0 + kc) = w;
        }
    }
}
DI void convert_jobs(const Params& P, int l, int jlo, int jhi, unsigned char* shm) {
    const int tid_ = fresh_tid(P);
    float* tile = (float*)shm; unsigned char* ws = P.ws();
#pragma nounroll
    for (int j = jlo; j < jhi; ++j) {
        int ii, K, N, Npad, mode = 0; size_t off;
        switch (j) {
        case 0: ii = 7; K = 2048; N = NIN; Npad = LDZ; off = W1_IN; break;
        case 1: ii = 17; K = 512; N = 1536; Npad = 1536; off = W1_CQ; break;
        case 2: ii = 18; K = 256; N = 2048; Npad = 2048; off = W1_CKV; break;
        case 3: ii = 19; K = 1024; N = 2048; Npad = 2048; off = W1_BR; break;
        case 4: ii = 20; K = 1024; N = 2048; Npad = 2048; off = W1_BR + (size_t)2048 * 1024 * 2; break;
        case 5: ii = 21; K = 1024; N = 2048; Npad = 2048; off = W1_BR + (size_t)2 * 2048 * 1024 * 2; break;
        case 6: ii = 22; K = 2048; N = 2048; Npad = 2048; off = W1_MIX; break;
        case 7: ii = 26; K = 2048; N = 512; Npad = 512; off = W1_XQ; break;
        case 8: ii = 27; K = 2048; N = 1024; Npad = 1024; off = W1_XKV; break;
        case 9: ii = 28; K = 512; N = 2048; Npad = 2048; off = W1_XOUT; break;
        case 10: ii = 31; K = 2048; N = DFF; Npad = DFF; off = W2_GU; mode = 1; break;
        case 11: ii = 32; K = 2048; N = DFF; Npad = DFF; off = W2_GU; mode = 2; break;
        default: ii = 33; K = DFF; N = 2048; Npad = 2048; off = W2_DN; break;
        }
        cvt_job(P.in(ii) + (size_t)l * K * N, K, N, Npad, (bf16_t*)(ws + off), mode, tile, tid_);
    }
}
DI void norm_rows(const Params& P, int nrows, int srcsel  , const float* g, bf16_t* dst) {
    const int tid_ = fresh_tid(P);
    const int wid = tid_ >> 6, lane = tid_ & 63;
    for (int t = blockIdx.x * 8 + wid; t < nrows; t += gridDim.x * 8) {
        const float* src = srcsel == 0 ? xin_row(P, t) : (t < 512 ? P.in(2) + (size_t)t * DM : P.in(3) + (size_t)(t - 512) * DM);
        f32x4 v[8]; float ss = 0.f;
#pragma unroll
        for (int j = 0; j < 8; ++j) { v[j] = *(const f32x4*)(src + j * 256 + lane * 4); ss += v[j][0] * v[j][0] + v[j][1] * v[j][1] + v[j][2] * v[j][2] + v[j][3] * v[j][3]; }
        ss = wave_sum(ss); const float rn = rsqrtf(ss * (1.f / 2048.f) + EPS);
#pragma unroll
        for (int j = 0; j < 8; ++j) { const f32x4 gg = *(const f32x4*)(g + j * 256 + lane * 4);
            u32x2 w; w.x = cvtpk(v[j][0] * rn * gg[0], v[j][1] * rn * gg[1]); w.y = cvtpk(v[j][2] * rn * gg[2], v[j][3] * rn * gg[3]);
            *(u32x2*)(dst + (size_t)t * DM + j * 256 + lane * 4) = w; }
    }
}
DI void norm_res(const Params& P, bool src_in, bool dst_out, const bf16_t* tmp, const float* gpost, const float* gpre, bf16_t* h) {
    const int tid_ = fresh_tid(P);
    const int wid = tid_ >> 6, lane = tid_ & 63;
    bf16_t* x16 = (bf16_t*)(P.ws() + WS_X16);
    const int stride = gridDim.x * 8;
    for (int t0 = blockIdx.x * 8 + wid; t0 < T; t0 += 2 * stride) {
        u32x2 wt[2][8]; f32x4 xv[2][8];
#pragma unroll
        for (int r = 0; r < 2; ++r) { const int t = t0 + r * stride;
#pragma unroll
            for (int j = 0; j < 8; ++j) wt[r][j] = *(const u32x2*)(tmp + (size_t)t * DM + j * 256 + lane * 4);
            if (src_in) { const float* xs = xin_row(P, t);
#pragma unroll
                for (int j = 0; j < 8; ++j) xv[r][j] = *(const f32x4*)(xs + j * 256 + lane * 4);
            } else {
#pragma unroll
                for (int j = 0; j < 8; ++j) { const u32x2 w = *(const u32x2*)(x16 + (size_t)t * DM + j * 256 + lane * 4); xv[r][j] = (f32x4){bflo(w.x), bfhi(w.x), bflo(w.y), bfhi(w.y)}; } } }
#pragma unroll
        for (int r = 0; r < 2; ++r) { const int t = t0 + r * stride;
            f32x4 y[8]; float ss = 0.f;
#pragma unroll
            for (int j = 0; j < 8; ++j) { const u32x2 w = wt[r][j];
                y[j] = (f32x4){bflo(w.x), bfhi(w.x), bflo(w.y), bfhi(w.y)}; ss += y[j][0] * y[j][0] + y[j][1] * y[j][1] + y[j][2] * y[j][2] + y[j][3] * y[j][3]; }
            ss = wave_sum(ss); const float rn = rsqrtf(ss * (1.f / 2048.f) + EPS);
            float s2 = 0.f;
#pragma unroll
            for (int j = 0; j < 8; ++j) { const f32x4 gg = *(const f32x4*)(gpost + j * 256 + lane * 4);
#pragma unroll
                for (int q = 0; q < 4; ++q) { y[j][q] = xv[r][j][q] + y[j][q] * rn * gg[q]; s2 += y[j][q] * y[j][q]; } }
            if (dst_out) { float* xd = P.out() + (size_t)t * DM;
#pragma unroll
                for (int j = 0; j < 8; ++j) *(f32x4*)(xd + j * 256 + lane * 4) = y[j];
            } else {
#pragma unroll
                for (int j = 0; j < 8; ++j) { u32x2 w; w.x = cvtpk(y[j][0], y[j][1]); w.y = cvtpk(y[j][2], y[j][3]); *(u32x2*)(x16 + (size_t)t * DM + j * 256 + lane * 4) = w; } }
            if (gpre) { s2 = wave_sum(s2); const float r2 = rsqrtf(s2 * (1.f / 2048.f) + EPS);
#pragma unroll
                for (int j = 0; j < 8; ++j) { const f32x4 gg = *(const f32x4*)(gpre + j * 256 + lane * 4);
                    u32x2 w; w.x = cvtpk(y[j][0] * r2 * gg[0], y[j][1] * r2 * gg[1]); w.y = cvtpk(y[j][2] * r2 * gg[2], y[j][3] * r2 * gg[3]);
                    *(u32x2*)(h + (size_t)t * DM + j * 256 + lane * 4) = w; } }
        }
    }
}
DI void prep_phase(const Params& P, int l) {
    const int tid_ = fresh_tid(P);
    const int wid = tid_ >> 6, lane = tid_ & 63, half = lane >> 5, j = lane & 31;
    bf16_t* z = (bf16_t*)(P.ws() + WS_Z); const f32x2* rope = (const f32x2*)(P.ws() + WS_ROPE);
    const float* gbq = P.in(13) + l * 128; const float* gbk = P.in(14) + l * 128; const float* gcq = P.in(15) + l * 512; const float* gckv = P.in(16) + l * 256;
    float gq[4], gk[4], gcqv[8], gckvv[4];
#pragma unroll
    for (int i = 0; i < 4; ++i) { gq[i] = gbq[j + 32 * i]; gk[i] = gbk[j + 32 * i]; gckvv[i] = gckv[lane * 4 + i]; }
#pragma unroll
    for (int q = 0; q < 8; ++q) gcqv[q] = gcq[lane * 8 + q];
    constexpr int NTK = 2;
    const int stride = gridDim.x * 8;
    for (int t0 = blockIdx.x * 8 + wid; t0 < T; t0 += NTK * stride) {
        unsigned hv[NTK][5][4], kr1[NTK], kr2[NTK]; u32x4 wq[NTK]; u32x2 wkv[NTK]; f32x2 cr[NTK], cc[NTK], ct[NTK];
#pragma unroll
        for (int r = 0; r < NTK; ++r) { const int t = t0 + r * stride; const bf16_t* zr = z + (size_t)t * LDZ;
            const int s = t < 4096 ? t : (t < 8192 ? t - 4096 : t - 8192);
            cr[r] = rope[(s >> 6) * 32 + j]; cc[r] = rope[(s & 63) * 32 + j]; ct[r] = rope[s * 32 + j];
#pragma unroll
            for (int it = 0; it < 5; ++it) { const int hh = it * 2 + half; const int base = hh < 8 ? ZC_BQ + hh * 128 : ZC_BK + (hh - 8) * 128;
#pragma unroll
                for (int i = 0; i < 4; ++i) hv[r][it][i] = zr[base + j + 32 * i]; }
            wq[r] = *(const u32x4*)(zr + ZC_CQA + lane * 8); wkv[r] = *(const u32x2*)(zr + ZC_CKVA + lane * 4);
            kr1[r] = zr[ZC_CKR + j]; kr2[r] = zr[ZC_CKR + 32 + j]; }
#pragma unroll
        for (int r = 0; r < NTK; ++r) { const int t = t0 + r * stride; bf16_t* zr = z + (size_t)t * LDZ;
#pragma unroll
            for (int it = 0; it < 5; ++it) { const int hh = it * 2 + half; const int base = hh < 8 ? ZC_BQ + hh * 128 : ZC_BK + (hh - 8) * 128; const bool isq = hh < 8;
                float v0 = bf2f((unsigned short)hv[r][it][0]), v1 = bf2f((unsigned short)hv[r][it][1]), v2 = bf2f((unsigned short)hv[r][it][2]), v3 = bf2f((unsigned short)hv[r][it][3]);
                float ss = half_sum(v0 * v0 + v1 * v1 + v2 * v2 + v3 * v3); const float rn = rsqrtf(ss * (1.f / 128.f) + EPS);
                v0 *= rn * (isq ? gq[0] : gk[0]); v1 *= rn * (isq ? gq[1] : gk[1]); v2 *= rn * (isq ? gq[2] : gk[2]); v3 *= rn * (isq ? gq[3] : gk[3]);
                zr[base + j] = f2bf(v0 * cr[r].x - v1 * cr[r].y); zr[base + 32 + j] = f2bf(v0 * cr[r].y + v1 * cr[r].x);
                zr[base + 64 + j] = f2bf(v2 * cc[r].x - v3 * cc[r].y); zr[base + 96 + j] = f2bf(v2 * cc[r].y + v3 * cc[r].x); }
            { const u32x4 w = wq[r]; float x[8] = {bflo(w.x), bfhi(w.x), bflo(w.y), bfhi(w.y), bflo(w.z), bfhi(w.z), bflo(w.w), bfhi(w.w)};
              float ss = 0.f;
#pragma unroll
              for (int q = 0; q < 8; ++q) ss += x[q] * x[q];
              ss = wave_sum(ss); const float rn = rsqrtf(ss * (1.f / 512.f) + EPS);
#pragma unroll
              for (int q = 0; q < 8; ++q) x[q] *= rn * gcqv[q];
              u32x4 o; o.x = cvtpk(x[0], x[1]); o.y = cvtpk(x[2], x[3]); o.z = cvtpk(x[4], x[5]); o.w = cvtpk(x[6], x[7]); *(u32x4*)(zr + ZC_CQA + lane * 8) = o; }
            { const u32x2 w = wkv[r]; float x[4] = {bflo(w.x), bfhi(w.x), bflo(w.y), bfhi(w.y)};
              float ss = wave_sum(x[0] * x[0] + x[1] * x[1] + x[2] * x[2] + x[3] * x[3]); const float rn = rsqrtf(ss * (1.f / 256.f) + EPS);
#pragma unroll
              for (int q = 0; q < 4; ++q) x[q] *= rn * gckvv[q];
              u32x2 o; o.x = cvtpk(x[0], x[1]); o.y = cvtpk(x[2], x[3]); *(u32x2*)(zr + ZC_CKVA + lane * 4) = o; }
            if (half == 0) { const float x1 = bf2f((unsigned short)kr1[r]), x2 = bf2f((unsigned short)kr2[r]);
                zr[ZC_CKR + j] = f2bf(x1 * ct[r].x - x2 * ct[r].y); zr[ZC_CKR + 32 + j] = f2bf(x1 * ct[r].y + x2 * ct[r].x); }
        }
    }
}
DI int t5_bucket(int rel) {
    const int n = rel < 0 ? -rel : rel; int b;
    if (n < 8) b = n; else if (n < 12) b = 8; else if (n < 16) b = 9; else if (n < 23) b = 10; else if (n < 32) b = 11; else if (n < 46) b = 12; else if (n < 64) b = 13; else if (n < 91) b = 14; else b = 15;
    return (rel > 0 ? 16 : 0) + b;
}
DI void init_phase(const Params& P, unsigned char* shm) {
    const int tid_ = fresh_tid(P);
    unsigned char* ws = P.ws();
    if (blockIdx.x == 0) {
        int* ctl = (int*)(ws + WS_CTL);
        if (tid_ < 16) ctl[tid_] = 0;
        { unsigned* xbw = (unsigned*)(ws + WS_XB); for (int i = tid_; i < 3456; i += NTHR) xbw[i] = 0u; }
        if (tid_ >= 64 && tid_ < 128) { const int i = tid_ - 64;
            for (int l = 0; l < NLAYER; ++l) {
                const float s1 = wave_sum(P.in(8)[l * 64 + i] * P.in(9)[l * 64 + i]), s2 = wave_sum(P.in(10)[l * 64 + i] * P.in(11)[l * 64 + i]);
                const float lam_init = l == 0 ? 0.2f : 0.35550907f;
                if (i == 0) ((float*)(ctl + 16))[l] = __expf(s1) - __expf(s2) + lam_init; } }
    }
    f32x2* rope = (f32x2*)(ws + WS_ROPE);
    for (int idx = blockIdx.x * NTHR + tid_; idx < 8192 * 32; idx += gridDim.x * NTHR) {
        const int pos = idx >> 5, i = idx & 31;
        const float inv = __builtin_amdgcn_exp2f(-(float)i * 0.41524101186092029f);
        const float ang = (float)pos * inv;
        const float kk = rintf(ang * 0.15915494309189535f);
        float rr = fmaf(-kk, 6.28125f, ang); rr = fmaf(-kk, 0.0019353071795864769f, rr);
        const float rev = rr * 0.15915494309189535f;
        rope[idx] = (f32x2){__builtin_amdgcn_cosf(rev), __builtin_amdgcn_sinf(rev)};
    }
}

template <int TYPE>
DI void attn_phase(const Params& P, int l, unsigned char* shm, const int rep, const bool cross = false) {
    const int tid_ = fresh_tid(P);
    unsigned char* ws = P.ws(); int* ctl = (int*)(ws + WS_CTL);
    bf16_t* z = (bf16_t*)(ws + WS_Z); bf16_t* ckv = (bf16_t*)(ws + WS_H); bf16_t* cq = (bf16_t*)(ws + WS_CQ); bf16_t* o = (bf16_t*)(ws + WS_O);
    int* sidx = (int*)(shm + ATT_IDX); float* tab = (float*)(shm + ATT_TAB);
    for (;;) {
        __syncthreads();
        if (tid_ == 0) *sidx = atomicAdd(ctl + (l * 4 + (cross ? 3 : TYPE)) * 2 + rep, 1);
        __syncthreads();
        const int idx = *sidx;
        if (idx >= (cross ? 256 : 512)) break;
        const bool sample = idx < 256; const int w = idx & 255, head = w >> 5, qbl = w & 31;
        const int t0 = (sample ? 32 + qbl : qbl) * 256;
        const int seqstart = sample ? 8192 : (qbl < 16 ? 0 : 4096), seqlen = sample ? 8192 : 4096;
        AttnArgs a; a.tid = tid_; a.qpos0 = t0 - seqstart; a.seq = seqlen; a.tab = tab; a.rope = nullptr; a.K2 = nullptr; a.ldk2 = 0; a.map = 0; a.lam = 0.f; a.ga = nullptr; a.oscale = 1.f;
        if constexpr (TYPE == 0) {
            const float lam_init = l == 0 ? 0.2f : 0.35550907f;
            a.lam = ((const float*)(ctl + 16))[l]; a.ga = P.in(12) + l * 128; a.oscale = 1.f - lam_init;
            const float* rb = P.in(4);
            for (int i = tid_; i < 257; i += NTHR) tab[i] = rb[t5_bucket(i - 128) * 8 + head] * LOG2E;
            a.ldq = LDZ; a.ldk = LDZ; a.ldv = LDZ; a.ldo = 3072; a.C = 0.125f * LOG2E;
            a.V = z + (size_t)seqstart * LDZ + ZC_AV + head * 128; a.O = o + (size_t)t0 * 3072 + head * 128;
#if A_DUAL
            a.Q = z + (size_t)t0 * LDZ + ZC_AQ + head * 128; a.K = z + (size_t)seqstart * LDZ + ZC_AK + head * 128;
            attn_body_dual(a, (char*)shm);
#else
#pragma nounroll
            for (int mp = 0; mp < 2; ++mp) { a.map = mp;
                a.Q = z + (size_t)t0 * LDZ + ZC_AQ + head * 128 + mp * 64; a.K = z + (size_t)seqstart * LDZ + ZC_AK + head * 128 + mp * 64;
                attn_body<64, 1>(a, (char*)shm); }
#endif
        } else if constexpr (TYPE == 1) {
            a.rope = (const f32x2*)(ws + WS_ROPE);
            a.Q = cq + (size_t)t0 * 1536 + head * 192; a.ldq = 1536; a.K = ckv + (size_t)seqstart * 2048 + head * 256; a.ldk = 2048;
            a.K2 = z + (size_t)seqstart * LDZ + ZC_CKR; a.ldk2 = LDZ; a.V = ckv + (size_t)seqstart * 2048 + head * 256 + 128; a.ldv = 2048;
            a.O = o + (size_t)t0 * 3072 + 2048 + head * 128; a.ldo = 3072; a.C = 0.07216878364870322f * LOG2E;
            attn_body<192, 2>(a, (char*)shm);
        } else if (cross) {
            const bf16_t* xq = (const bf16_t*)(ws + WS_XQ); const bf16_t* mkv = (const bf16_t*)(ws + WS_MEMKV); bf16_t* xatt = (bf16_t*)(ws + WS_XATT);
            const int xh = idx >> 6, qb = idx & 63, xt0 = qb * 256, sq = qb < 16 ? 0 : (qb < 32 ? 1 : 2);
            a.qpos0 = 0; a.seq = 256;
            a.Q = xq + (size_t)xt0 * 512 + xh * 128; a.ldq = 512; a.K = mkv + (size_t)sq * 256 * 1024 + xh * 128; a.ldk = 1024;
            a.V = mkv + (size_t)sq * 256 * 1024 + 512 + xh * 128; a.ldv = 1024; a.O = xatt + (size_t)xt0 * 512 + xh * 128; a.ldo = 512; a.C = 0.08838834764831845f * LOG2E;
            attn_body<128, 0>(a, (char*)shm);
        } else {
            const int kvh = head >> 2;
            a.Q = z + (size_t)t0 * LDZ + ZC_BQ + head * 128; a.ldq = LDZ; a.K = z + (size_t)seqstart * LDZ + ZC_BK + kvh * 128; a.ldk = LDZ;
            a.V = z + (size_t)seqstart * LDZ + ZC_BV + kvh * 128; a.ldv = LDZ; a.O = o + (size_t)t0 * 3072 + 1024 + head * 128; a.ldo = 3072; a.C = 0.08838834764831845f * LOG2E;
            attn_body<128, 0>(a, (char*)shm);
        }
    }
}
#define XB_TMO      128
#define XB_XCNT(j)  (256  + 64 * (j))
#define XB_XSUB(j)  (1280 + 64 * (j))
#define XB_XGEN(j)  (2304 + 64 * (j))
#define XB_TOP      3328
#define XB_TOPGEN   3392
#define XCD_BAR_WORDS 3456
#define XB_SPIN_CAP (1u << 20)
DI unsigned xb_ld(unsigned* p)              { return __hip_atomic_load(p, __ATOMIC_RELAXED, __HIP_MEMORY_SCOPE_AGENT); }
DI unsigned xb_add(unsigned* p, unsigned v) { return __hip_atomic_fetch_add(p, v, __ATOMIC_RELAXED, __HIP_MEMORY_SCOPE_AGENT); }
DI unsigned xb_xcc_id() { return (unsigned)__builtin_amdgcn_s_getreg((3 << 11) | 20) & 0xFu; }
#define XB_SPIN(cond, bar) do { unsigned _sp = 0; while (cond) { __builtin_amdgcn_s_sleep(1); \
    if ((++_sp & 255u) == 0u) { if (xb_ld(&(bar)[XB_TMO])) break; if (_sp > XB_SPIN_CAP) { atomicAdd(&(bar)[XB_TMO], 1u); break; } } } } while (0)
DI void xcd_post(unsigned* bar) { if (threadIdx.x == 0) (void)xb_add(&bar[XB_XCNT(xb_xcc_id())], 1u); }
DI void xcd_complete(unsigned* bar, unsigned x, unsigned& nloc, unsigned& nx) {
    const unsigned G = gridDim.x;
    unsigned sum, cnt, mine, sp = 0u;
    for (;;) {
        sum = 0u; cnt = 0u; mine = 0u;
#pragma unroll
        for (unsigned j = 0; j < 16; ++j) { const unsigned c = xb_ld(&bar[XB_XCNT(j)]); sum += c; cnt += (c > 0u) ? 1u : 0u; mine = (j == x) ? c : mine; }
        if (sum == G) break;
        __builtin_amdgcn_s_sleep(1);
        if ((++sp & 255u) == 0u) { if (xb_ld(&bar[XB_TMO])) break; if (sp > XB_SPIN_CAP) { atomicAdd(&bar[XB_TMO], 1u); break; } }
    }
    nloc = mine > 0u ? mine : 1u; nx = cnt > 0u ? cnt : 1u;
}
DI void xcd_barrier(unsigned* bar, volatile LAS unsigned* st) {
    asm volatile("s_waitcnt vmcnt(0)" ::: "memory");
    __syncthreads();
    if (threadIdx.x == 0) {
        const unsigned x = xb_xcc_id();
        __builtin_amdgcn_s_waitcnt(0);
        unsigned nloc = st[0], nx = st[1];
        if (nloc == 0u) { xcd_complete(bar, x, nloc, nx); st[0] = nloc; st[1] = nx; }
        const unsigned old = xb_add(&bar[XB_XSUB(x)], 1u);
        const unsigned gen = old / nloc;
        if (old + 1u == (gen + 1u) * nloc) {
            __builtin_amdgcn_fence(__ATOMIC_RELEASE, "agent");
            asm volatile("s_waitcnt vmcnt(0)" ::: "memory");
            const unsigned og = xb_add(&bar[XB_TOP], 1u);
            const unsigned tg = og / nx;
            if (og + 1u == (tg + 1u) * nx) xb_add(&bar[XB_TOPGEN], 1u);
            else XB_SPIN(xb_ld(&bar[XB_TOPGEN]) == tg, bar);
            __builtin_amdgcn_fence(__ATOMIC_ACQUIRE, "agent");
            xb_add(&bar[XB_XGEN(x)], 1u);
            asm volatile("s_waitcnt vmcnt(0)" ::: "memory");
        } else {
            XB_SPIN(xb_ld(&bar[XB_XGEN(x)]) == gen, bar);
            __builtin_amdgcn_fence(__ATOMIC_ACQUIRE, "agent");
            asm volatile("s_waitcnt vmcnt(0)" ::: "memory");
        }
    }
    __syncthreads();
}

DI void gbar(unsigned* bar, unsigned target) {
    asm volatile("s_waitcnt vmcnt(0)" ::: "memory");
    __syncthreads();
    if (threadIdx.x == 0) {
        __builtin_amdgcn_fence(__ATOMIC_RELEASE, "agent");
        asm volatile("s_waitcnt vmcnt(0)" ::: "memory");
        __hip_atomic_fetch_add(bar, 1u, __ATOMIC_RELAXED, __HIP_MEMORY_SCOPE_AGENT);
        while (__hip_atomic_load(bar, __ATOMIC_RELAXED, __HIP_MEMORY_SCOPE_AGENT) < target) __builtin_amdgcn_s_sleep(1);
        __builtin_amdgcn_fence(__ATOMIC_ACQUIRE, "agent");
        asm volatile("s_waitcnt vmcnt(0)" ::: "memory");
    }
    __syncthreads();
}

constexpr int NPH = 1 + 16 * NLAYER;
DI void run_phase(const Params& P, int ph, unsigned char* shm, const int rep) {
    unsigned char* ws = P.ws();
    bf16_t* z = (bf16_t*)(ws + WS_Z); bf16_t* h = (bf16_t*)(ws + WS_H); bf16_t* tmp = (bf16_t*)(ws + WS_TMP);
    const int l = ph == 0 ? 0 : (ph - 1) / 16, s = ph == 0 ? -1 : (ph - 1) % 16;
    const bool more = l + 1 < NLAYER;
    if (s == -1) init_phase(P, shm);
    if (s == 8 || s == 12 || s == 15) {
        const int gi_post = s == 8 ? 6 : (s == 12 ? 24 : 30), gi_pre = s == 8 ? 23 : (s == 12 ? 29 : 5);
        const bool has_pre = s != 15 || more;
        norm_res(P, s == 8 && l == 0, s == 15 && !more, tmp, P.in(gi_post) + l * DM, has_pre ? P.in(gi_pre) + (s == 15 ? l + 1 : l) * DM : nullptr, h);
    }
    { int jlo = 0, jhi = 0, lw = l;
      if (s == -1) { jhi = 10; } else if (s == 8) { jlo = 10; jhi = 13; } else if (s == 15 && more) { jhi = 10; lw = l + 1; }
      if (jhi > jlo) convert_jobs(P, lw, jlo, jhi, shm); }
    if (s == -1) norm_rows(P, T, 0, P.in(5), h);
    if (s == -1 || (s == 15 && more)) norm_rows(P, 768, 1, P.in(25) + (s == -1 ? 0 : l + 1) * DM, (bf16_t*)(ws + WS_MEMN));
    if (s == 1) prep_phase(P, l);
    { const int ng = (s == 0 || s == 2) ? 2 : ((s == 6 || s == 7 || s == 9 || s == 11 || s == 13 || s == 14) ? 1 : 0);
#pragma nounroll
      for (int gi = 0; gi < ng; ++gi) {
          unsigned char* w = P.ws();
          bf16_t* zz = (bf16_t*)(w + WS_Z); bf16_t* hh = (bf16_t*)(w + WS_H); bf16_t* tt = (bf16_t*)(w + WS_TMP);
          GD d; gd_set(d, hh, DM, (const bf16_t*)(w + W1_MIX), T, DM, DM, tt, DM);
          switch (s * 2 + gi) {
          case 0: gd_set(d, hh, DM, (const bf16_t*)(w + W1_IN), T, LDZ, DM, zz, LDZ, 0, ZC_G); break;
          case 1: gd_set(d, (const bf16_t*)(w + WS_MEMN), DM, (const bf16_t*)(w + W1_XKV), 768, 1024, DM, (bf16_t*)(w + WS_MEMKV), 1024); d.coff = (int)gridDim.x / 2; break;
          case 4: gd_set(d, zz + ZC_CQA, LDZ, (const bf16_t*)(w + W1_CQ), T, 1536, 512, (bf16_t*)(w + WS_CQ), 1536); break;
          case 5: gd_set(d, zz + ZC_CKVA, LDZ, (const bf16_t*)(w + W1_CKV), T, 2048, 256, hh, 2048); break;
          case 12: gd_set(d, (const bf16_t*)(w + WS_O), 3072, (const bf16_t*)(w + W1_BR), T, DM, 1024, hh, DM, 2); d.nseg = 3; d.segA = 1024; d.segB = (long)2048 * 1024; d.Z = zz; break;
          case 18: gd_set(d, hh, DM, (const bf16_t*)(w + W1_XQ), T, 512, DM, (bf16_t*)(w + WS_XQ), 512); break;
          case 22: gd_set(d, (const bf16_t*)(w + WS_XATT), 512, (const bf16_t*)(w + W1_XOUT), T, DM, 512, tt, DM); break;
          case 26: gd_set(d, hh, DM, (const bf16_t*)(w + W2_GU), T, 2 * DFF, DM, (bf16_t*)(w + WS_U), DFF, 1); break;
          case 28: gd_set(d, (const bf16_t*)(w + WS_U), DFF, (const bf16_t*)(w + W2_DN), T, DM, DFF, tt, DM); break;
          default: break;
          }
          run_gemm(fresh_tid(P), shm, d); }
    }
    if (s == 3) attn_phase<0>(P, l, shm, rep);
    if (s == 3) attn_phase<1>(P, l, shm, rep);
    if (s == 3 || s == 10) attn_phase<2>(P, l, shm, rep, s == 10);
}

__global__ __launch_bounds__(NTHR, 2) void mega(KArgs A, int ph_lo, int ph_hi) {
    extern __shared__ __attribute__((aligned(16))) unsigned char shm[];
    cg::grid_group grid = cg::this_grid();
    { LAS unsigned long long* pt = (LAS unsigned long long*)(shm + PTAB_OFF);
#pragma unroll
      for (int i = 0; i < 34; ++i) if (threadIdx.x == i) pt[i] = (unsigned long long)A.in[i];
      if (threadIdx.x == 34) pt[34] = (unsigned long long)A.out;
      if (threadIdx.x == 35) pt[35] = (unsigned long long)A.ws;
      if (threadIdx.x == 36) { ((LAS unsigned*)(shm + PTAB_OFF + 384))[0] = 0u; ((LAS unsigned*)(shm + PTAB_OFF + 384))[1] = 0u; }
      __syncthreads(); }
    Params P; P.t = (LAS const unsigned long long*)(shm + PTAB_OFF);
    volatile LAS unsigned* xst = (volatile LAS unsigned*)(shm + PTAB_OFF + 384);
    const int wave_s = __builtin_amdgcn_readfirstlane((int)(threadIdx.x >> 6));
    int nbar = 0;
    for (int ph = ph_lo; ph < ph_hi; ++ph) {
        if (ph > 0 && (((ph - 1) % 16) == 4 || ((ph - 1) % 16) == 5)) continue;
        const int nrep = (REP_MASK != 0 && ph > 0 && ((REP_MASK >> ((ph - 1) % 16)) & 1)) ? 2 : 1;
        for (int rep = 0; rep < nrep; ++rep) {
            if (ph > ph_lo || rep > 0) { unsigned* xbw = (unsigned*)(P.ws() + WS_XB); if (nbar == 0) { grid.sync(); xcd_post(xbw); } else xcd_barrier(xbw, xst); ++nbar; }
            { int l_; asm volatile("v_mbcnt_lo_u32_b32 %0, -1, 0\n\tv_mbcnt_hi_u32_b32 %0, -1, %0" : "=v"(l_)); P.tid = wave_s * 64 + l_; }
            run_phase(P, ph, shm, rep);
        }
    }
}

extern "C" void kernel_launch(void* const* d_in, const int* in_sizes, int n_in, void* d_out, int out_size, void* d_ws, size_t ws_size, hipStream_t stream) {
    static int grid = 0;
    if (grid == 0) {
        if (n_in != 34 || out_size != T * DM || ws_size < WS_END) { fprintf(stderr, "kernel_launch: unexpected shapes n_in %d out %d ws %zu (need %zu)\n", n_in, out_size, ws_size, (size_t)WS_END); grid = -1; return; }
        if (hipFuncSetAttribute((const void*)mega, hipFuncAttributeMaxDynamicSharedMemorySize, LDS_BYTES) != hipSuccess) { fprintf(stderr, "kernel_launch: hipFuncSetAttribute failed\n"); grid = -1; return; }
        int dev = 0, cus = 0, per_cu = 0;
        hipGetDevice(&dev); hipDeviceGetAttribute(&cus, hipDeviceAttributeMultiprocessorCount, dev);
        hipOccupancyMaxActiveBlocksPerMultiprocessor(&per_cu, (const void*)mega, NTHR, LDS_BYTES);
        if (per_cu < 1) { fprintf(stderr, "kernel_launch: occupancy query says %d\n", per_cu); per_cu = 1; }
        (void)hipGetLastError();
        grid = cus;
    }
    if (grid < 0) return;
    KArgs p{};
    for (int i = 0; i < 34; ++i) p.in[i] = (const float*)d_in[i];
    p.out = (float*)d_out; p.ws = (unsigned char*)d_ws;
#if ONE_LAUNCH
    int lo = 0, hi = NPH; void* args[] = {&p, &lo, &hi};
    hipError_t e = hipLaunchCooperativeKernel((const void*)mega, dim3(grid), dim3(NTHR), args, LDS_BYTES, stream);
    if (e != hipSuccess) fprintf(stderr, "cooperative launch failed: %s (grid %d)\n", hipGetErrorString(e), grid);
#else
    for (int ph = 0; ph < NPH; ++ph) hipLaunchKernelGGL(mega, dim3(grid), dim3(NTHR), LDS_BYTES, stream, p, ph, ph + 1);
#endif
}
```
